# Optimizing an MI355X kernel written in HIP

```python
import jax, jax.numpy as jnp
from jax import lax
import numpy as np

D_MODEL = 1024
BATCH = 2
SEQ = 8192
DEPTH = 1

ATTN_HEADS = 8
HEAD_DIM = 64
ATTN_WIDTH = ATTN_HEADS * HEAD_DIM
GMLP_GROUPS = 8
GMLP_GROUP_DIM = 64
GMLP_WIDTH = GMLP_GROUPS * GMLP_GROUP_DIM
MIX_WIDTH = ATTN_WIDTH + GMLP_WIDTH
IDX_HEADS = 8
IDX_DIM = 64
TOPK_MAX = 256
CHUNK = 128
Q_BLOCK = 128
D_FF = 4 * D_MODEL
ROPE_THETA = 10000.0
EPS = 1e-6
IN_SPLITS = (ATTN_WIDTH, ATTN_WIDTH, ATTN_WIDTH, IDX_HEADS * IDX_DIM, IDX_DIM, IDX_HEADS, GMLP_WIDTH, GMLP_WIDTH)
IN_COLS = sum(IN_SPLITS)

kernel_name = "hymba_gmlp_dsa_hybrid_block"


def rmsnorm(x, g):
    xf = x.astype(jnp.float32)
    y = xf * lax.rsqrt(jnp.mean(xf * xf, axis=-1, keepdims=True) + EPS)
    return (y * g.astype(jnp.float32)).astype(x.dtype)


def rope(x, pos):
    half = x.shape[-1] // 2
    inv_freq = ROPE_THETA ** (-jnp.arange(half, dtype=jnp.float32) / half)
    ang = pos.astype(jnp.float32)[:, None] * inv_freq[None, :]
    cos = jnp.cos(ang)[None, :, None, :]
    sin = jnp.sin(ang)[None, :, None, :]
    xf = x.astype(jnp.float32)
    x1, x2 = xf[..., :half], xf[..., half:]
    out = jnp.concatenate([x1 * cos - x2 * sin, x1 * sin + x2 * cos], axis=-1)
    return out.astype(x.dtype)


def gmlp_mixer(u, v, gm_norm_g, w_spatial, b_spatial):
    B, S, _ = u.shape
    nc = S // CHUNK
    u = jax.nn.gelu(u)
    v = jax.nn.gelu(v).reshape(B, nc, CHUNK, GMLP_GROUPS, GMLP_GROUP_DIM)
    vf = v.astype(jnp.float32)
    mu = jnp.mean(vf, axis=-1, keepdims=True)
    var = jnp.mean(jnp.square(vf - mu), axis=-1, keepdims=True)
    vn = ((vf - mu) * lax.rsqrt(var + EPS)
          * gm_norm_g.astype(jnp.float32).reshape(GMLP_GROUPS, GMLP_GROUP_DIM)).astype(u.dtype)
    causal = jnp.tril(jnp.ones((CHUNK, CHUNK), dtype=bool))
    w = jnp.where(causal[None], w_spatial, jnp.zeros_like(w_spatial))
    mixed = jnp.einsum("gts,bnsgd->bntgd", w, vn) + b_spatial.T[None, None, :, :, None]
    return u * mixed.reshape(B, S, GMLP_WIDTH)


def dsa_mixer(q, k, v, q_idx, k_idx, w_idx):
    B, S = q.shape[0], q.shape[1]
    topk = min(TOPK_MAX, S // 4)
    nb = S // Q_BLOCK
    key_pos = jnp.arange(S)
    attn_scale = HEAD_DIM ** -0.5

    def block(start):
        qb = lax.dynamic_slice_in_dim(q, start, Q_BLOCK, axis=1)
        qib = lax.dynamic_slice_in_dim(q_idx, start, Q_BLOCK, axis=1)
        wb = lax.dynamic_slice_in_dim(w_idx, start, Q_BLOCK, axis=1)
        qpos = start + jnp.arange(Q_BLOCK)
        logits = jnp.einsum("bthd,bsd->bths", qib, k_idx).astype(jnp.float32) * (IDX_DIM ** -0.5)
        iscore = jnp.einsum("bth,bths->bts",
                            wb.astype(jnp.float32) * (IDX_HEADS ** -0.5), jax.nn.relu(logits))
        admissible = key_pos[None, :] <= qpos[:, None]
        iscore = jnp.where(admissible[None], iscore, -jnp.inf)
        _, idx = lax.top_k(iscore, topk)
        kg = jax.vmap(lambda kb, ib: kb[ib])(k, idx)
        vg = jax.vmap(lambda vb, ib: vb[ib])(v, idx)
        s = jnp.einsum("bthd,btkhd->bhtk", qb, kg).astype(jnp.float32) * attn_scale
        valid = idx <= qpos[None, :, None]
        s = jnp.where(valid[:, None], s, -jnp.inf)
        p = jax.nn.softmax(s, axis=-1).astype(v.dtype)
        return jnp.einsum("bhtk,btkhd->bthd", p, vg)

    out = lax.map(block, jnp.arange(nb) * Q_BLOCK)
    return out.transpose(1, 0, 2, 3, 4).reshape(B, S, ATTN_WIDTH)


def setup_inputs(seed: int = 0) -> dict:
    key = jax.random.key(seed)
    ks = jax.random.split(key, 20)
    f32 = jnp.float32
    nrm = lambda k, shape, s: jax.random.normal(k, shape, f32) * s
    return {
        "x": nrm(ks[0], (BATCH, SEQ, D_MODEL), 1.0),
        "c": nrm(ks[1], (BATCH, D_MODEL), 1.0),
        "ada_w": nrm(ks[2], (DEPTH, D_MODEL, 6 * D_MODEL), 0.5 * D_MODEL ** -0.5),
        "ada_b": nrm(ks[3], (DEPTH, 6 * D_MODEL), 0.01),
        "norm1_g": 1.0 + nrm(ks[4], (DEPTH, D_MODEL), 0.02),
        "w_in": nrm(ks[5], (DEPTH, D_MODEL, IN_COLS), D_MODEL ** -0.5),
        "w_spatial": nrm(ks[6], (DEPTH, GMLP_GROUPS, CHUNK, CHUNK), CHUNK ** -0.5),
        "b_spatial": 1.0 + nrm(ks[7], (DEPTH, GMLP_GROUPS, CHUNK), 0.1),
        "gm_norm_g": 1.0 + nrm(ks[8], (DEPTH, GMLP_WIDTH), 0.02),
        "beta_attn": 1.0 + nrm(ks[9], (DEPTH, ATTN_WIDTH), 0.02),
        "beta_gmlp": 1.0 + nrm(ks[10], (DEPTH, GMLP_WIDTH), 0.02),
        "w_out": nrm(ks[11], (DEPTH, MIX_WIDTH, D_MODEL), MIX_WIDTH ** -0.5),
        "norm2_g": 1.0 + nrm(ks[12], (DEPTH, D_MODEL), 0.02),
        "w_ff1": nrm(ks[13], (DEPTH, D_MODEL, D_FF), D_MODEL ** -0.5),
        "w_ff2": nrm(ks[14], (DEPTH, D_FF, D_MODEL), D_FF ** -0.5),
        "final_g": 1.0 + nrm(ks[15], (D_MODEL,), 0.02),
    }


def reference(x, c, ada_w, ada_b, norm1_g, w_in, w_spatial, b_spatial, gm_norm_g,
              beta_attn, beta_gmlp, w_out, norm2_g, w_ff1, w_ff2, final_g):
    B, S, _ = x.shape
    pos = jnp.arange(S)
    split_points = list(np.cumsum(IN_SPLITS)[:-1])
    c_act = jax.nn.silu(c)
    for l in range(DEPTH):
        mod = c_act @ ada_w[l] + ada_b[l]
        sh1, sc1, g1, sh2, sc2, g2 = [m[:, None, :] for m in jnp.split(mod, 6, axis=-1)]

        h = rmsnorm(x, norm1_g[l]) * (1.0 + sc1) + sh1
        proj = h @ w_in[l]
        q, k, v, qi, ki, wi, gu, gv = jnp.split(proj, split_points, axis=-1)
        q = rope(q.reshape(B, S, ATTN_HEADS, HEAD_DIM), pos)
        k = rope(k.reshape(B, S, ATTN_HEADS, HEAD_DIM), pos)
        v = v.reshape(B, S, ATTN_HEADS, HEAD_DIM)
        qi = rope(qi.reshape(B, S, IDX_HEADS, IDX_DIM), pos)
        ki = rope(ki[:, :, None, :], pos)[:, :, 0, :]
        attn_out = dsa_mixer(q, k, v, qi, ki, wi)
        gm_out = gmlp_mixer(gu, gv, gm_norm_g[l], w_spatial[l], b_spatial[l])
        merged = jnp.concatenate([rmsnorm(attn_out, beta_attn[l]),
                                  rmsnorm(gm_out, beta_gmlp[l])], axis=-1)
        x = x + g1 * (merged @ w_out[l])

        h2 = rmsnorm(x, norm2_g[l]) * (1.0 + sc2) + sh2
        ff = jnp.square(jax.nn.relu(h2 @ w_ff1[l])) @ w_ff2[l]
        x = x + g2 * ff
    return rmsnorm(x, final_g)
```

```cpp
#include <hip/hip_runtime.h>
#include <hip/hip_bf16.h>
#include <cstdio>
#include <cstdint>
#include <cmath>

#ifndef MK_N_LAUNCHES
#define MK_N_LAUNCHES 1
#endif
#ifndef MK_LAST_PHASE
#define MK_LAST_PHASE 9
#endif
constexpr int BATCH = 2, T = 8192, D = 1024, FF = 4096, M = BATCH * T;
constexpr int NH = 8, HD = 64, AW = 512;
constexpr int IN_COLS = 3144, NIN = 3072;
constexpr int SEC_Q = 0, SEC_K = 512, SEC_V = 1024, SEC_QI = 1536, SEC_KI = 2048, SEC_WI = 2112, SEC_GU = 2120, SEC_GV = 2632;
constexpr int TOPK = 256;
constexpr size_t MiB = 1u << 20;
constexpr size_t WS_CTL = 0, CTL_ZERO_BYTES = 1 * MiB;
constexpr size_t CTL_MOD = 64 * 1024;
constexpr size_t CTL_BIAS1 = 128 * 1024;
constexpr int CW_TMO = 0, CW_CODE = 1, CW_KMAX = 8192, CW_DBG = 8256;
constexpr int CW_BAR = 4096;
constexpr size_t WS_WIN = 1 * MiB, WS_WSM = 7 * MiB, WS_WOUT = 8 * MiB, WS_WFF2 = 10 * MiB, WS_WFF1 = 18 * MiB;
constexpr size_t WS_COS = 34 * MiB, WS_SIN = 35 * MiB;
constexpr size_t WS_SSA = 36 * MiB, WS_SSG = 36 * MiB + 512 * 1024, WS_SSX1 = 37 * MiB, WS_SSX2 = 38 * MiB, WS_WI = 39 * MiB, WS_WSP = 39 * MiB + 512 * 1024;
constexpr size_t WS_X1H = 40 * MiB;
constexpr size_t WS_MASK = 40 * MiB, WS_KI = 58 * MiB;
constexpr size_t WS_U = 72 * MiB;
constexpr size_t WS_H1 = 72 * MiB, WS_MRG = 72 * MiB;
constexpr size_t WS_Q = 104 * MiB, WS_K = 120 * MiB, WS_V = 136 * MiB;
constexpr size_t WS_QI = 152 * MiB, WS_GU = 168 * MiB, WS_VN = 184 * MiB;
constexpr size_t WS_END = 200 * MiB;
constexpr int RING_OFF = 0;
constexpr int LDS_BYTES = 163840;
constexpr int LDSCTL_OFF = LDS_BYTES - 1024, MISC_OFF = LDSCTL_OFF + 320;
constexpr int NWAVES = 8;
namespace pg8 {
#define PG8_LAS __attribute__((address_space(3)))
typedef unsigned short bf16_t;
typedef short bf16x8 __attribute__((ext_vector_type(8)));
typedef float f32x4 __attribute__((ext_vector_type(4)));
typedef unsigned u32x4 __attribute__((ext_vector_type(4)));
constexpr int BM = 256, BK = 64, HALF = 128, HTB = HALF * BK * 2  , STAGE_BYTES = 8 * HTB, NXCD = 8, WGM = 8;

__host__ __device__ __forceinline__ int lds_byte(int r, int c) { const int st = (r >> 4) * 2 + (c >> 5), rr = r & 15, cc = c & 31, ob = rr * 64 + cc * 2; return st * 1024 + (ob ^ (((ob >> 9) & 1) << 5)); }
__host__ __device__ __forceinline__ void stage_rc(int b, int& R, int& C) { const int st = b / 1024, sb = b % 1024, swz = sb ^ (((sb >> 9) & 1) << 5); R = (st >> 1) * 16 + swz / 64; C = (st & 1) * 32 + (swz % 64) / 2; }
__host__ __device__ __forceinline__ int perm32(int rho) { const int n = rho >> 4, i = rho & 15; return 8 * (i >> 2) + 4 * n + (i & 3); }

struct Unit { int pm, pn; };
struct Gemm { const bf16_t* A; const bf16_t* Bt; int M, N, K; size_t bbatch; };

struct StaticOrder {
    int nM, nN, nwg, G, c;
    __host__ __device__ void init(int M, int N, int G_, int c_) { nM = M / BM; nN = N / BM; nwg = nM * nN; G = G_; c = c_; }
    __host__ __device__ bool next(int i, Unit& u) const {
        const long L = (long)i * G + c; if (L >= nwg) return false;
        int wgid = (int)L; { const int q = nwg / NXCD, r = nwg % NXCD, xcd = wgid % NXCD, off = wgid / NXCD; wgid = (xcd < r ? xcd * (q + 1) : r * (q + 1) + (xcd - r) * q) + off; }
        const int nig = WGM * nN, gid = wgid / nig, fm = gid * WGM, gsz = (nM - fm) < WGM ? (nM - fm) : WGM;
        u.pm = fm + ((wgid % nig) % gsz); u.pn = (wgid % nig) / gsz; return true;
    }
    __device__ __forceinline__ void a_ready(const Unit&) const {}
    __device__ __forceinline__ void done(const Unit&) const {}
};

typedef float f32x2 __attribute__((ext_vector_type(2)));
typedef _Float16 f16x2 __attribute__((ext_vector_type(2)));
typedef _Float16 f16x8 __attribute__((ext_vector_type(8)));
typedef __bf16 bf16x2v __attribute__((ext_vector_type(2)));
__device__ __forceinline__ unsigned pk_f16(float lo, float hi) { f16x2 v = {(_Float16)lo, (_Float16)hi}; return __builtin_bit_cast(unsigned, v); }
__device__ __forceinline__ unsigned pk_bf16(float lo, float hi) { f32x2 v = {lo, hi}; bf16x2v b = __builtin_convertvector(v, bf16x2v); return __builtin_bit_cast(unsigned, b); }
__device__ __forceinline__ float gelu_tanh(float v) {
    const float y = 0.7978845608028654f * (v + 0.044715f * v * v * v);
    const float e = __builtin_amdgcn_exp2f(-2.8853900817779268f * y);
    return v * __builtin_amdgcn_rcpf(1.0f + e);
}
constexpr float QK_C2 = 0.125f * 1.4426950408889634f;
constexpr float RMS_EPS = 1e-6f;

struct EpiInProj {
    static constexpr bool PERM = true, AFTER_DRAIN = false, MIDK = false;
    unsigned short *Q, *K, *V, *QI, *GU, *VN; const float *cosT, *sinT, *gmg;
    __device__ __forceinline__ void midk(f32x4 (&)[2][2][4][2], const Unit&, int, int, int, int) const {}
    __device__ __forceinline__ void operator()(const f32x4 (&acc)[2][2][4][2], const Unit& u, int wr, int wc, int fr, int fq) const {
        const int sec = u.pn >> 1, head = 4 * (u.pn & 1) + wc, dlo = 8 * fq, colb = head * 64 + dlo;
        unsigned short* dst = sec == 0 ? Q : sec == 1 ? K : sec == 2 ? V : sec == 3 ? QI : sec == 4 ? GU : VN;
        const bool rope = (sec <= 1) || (sec == 3);
        float gl[8], gh[8];
        if (sec == 5) {
#pragma unroll
            for (int e = 0; e < 8; ++e) { gl[e] = gmg[colb + e]; gh[e] = gmg[colb + 32 + e]; }
        }
#pragma unroll
        for (int ai = 0; ai < 2; ++ai)
#pragma unroll
            for (int m = 0; m < 4; ++m) {
                const int row = u.pm * BM + ai * HALF + wr * 64 + m * 16 + fr;
                float lo[8], hi[8];
#pragma unroll
                for (int n = 0; n < 2; ++n)
#pragma unroll
                    for (int j = 0; j < 4; ++j) { lo[4 * n + j] = acc[ai][0][m][n][j]; hi[4 * n + j] = acc[ai][1][m][n][j]; }
                if (rope) {
                    const int pos = row & 8191;
                    const f32x4 c0 = *(const f32x4*)(cosT + pos * 32 + dlo), c1 = *(const f32x4*)(cosT + pos * 32 + dlo + 4);
                    const f32x4 s0 = *(const f32x4*)(sinT + pos * 32 + dlo), s1 = *(const f32x4*)(sinT + pos * 32 + dlo + 4);
                    const float sc = (sec == 0) ? QK_C2 : 1.0f;
#pragma unroll
                    for (int e = 0; e < 8; ++e) { const float c = e < 4 ? c0[e & 3] : c1[e & 3], s = e < 4 ? s0[e & 3] : s1[e & 3];
                        const float a = lo[e], b = hi[e]; lo[e] = (a * c - b * s) * sc; hi[e] = (a * s + b * c) * sc; }
                } else if (sec >= 4) {
#pragma unroll
                    for (int e = 0; e < 8; ++e) { lo[e] = gelu_tanh(lo[e]); hi[e] = gelu_tanh(hi[e]); }
                    if (sec == 5) {
                        float s = 0.f;
#pragma unroll
                        for (int e = 0; e < 8; ++e) s += lo[e] + hi[e];
                        s += __shfl_xor(s, 16); s += __shfl_xor(s, 32);
                        const float mu = s * (1.0f / 64.0f); float q = 0.f;
#pragma unroll
                        for (int e = 0; e < 8; ++e) { lo[e] -= mu; hi[e] -= mu; q += lo[e] * lo[e] + hi[e] * hi[e]; }
                        q += __shfl_xor(q, 16); q += __shfl_xor(q, 32);
                        const float rs = 1.0f / sqrtf(q * (1.0f / 64.0f) + RMS_EPS);
#pragma unroll
                        for (int e = 0; e < 8; ++e) { lo[e] = lo[e] * rs * gl[e]; hi[e] = hi[e] * rs * gh[e]; }
                    }
                }
                u32x4 wl, wh;
                if (sec <= 2) { wl.x = pk_bf16(lo[0], lo[1]); wl.y = pk_bf16(lo[2], lo[3]); wl.z = pk_bf16(lo[4], lo[5]); wl.w = pk_bf16(lo[6], lo[7]);
                                wh.x = pk_bf16(hi[0], hi[1]); wh.y = pk_bf16(hi[2], hi[3]); wh.z = pk_bf16(hi[4], hi[5]); wh.w = pk_bf16(hi[6], hi[7]); }
                else          { wl.x = pk_f16(lo[0], lo[1]); wl.y = pk_f16(lo[2], lo[3]); wl.z = pk_f16(lo[4], lo[5]); wl.w = pk_f16(lo[6], lo[7]);
                                wh.x = pk_f16(hi[0], hi[1]); wh.y = pk_f16(hi[2], hi[3]); wh.z = pk_f16(hi[4], hi[5]); wh.w = pk_f16(hi[6], hi[7]); }
                unsigned short* rp = dst + (size_t)row * 512 + colb;
                *(u32x4*)rp = wl; *(u32x4*)(rp + 32) = wh;
            }
    }
};

__device__ __forceinline__ float rstd_from8(const float* p, float inv_n) {
    const f32x4 a = *(const f32x4*)p, b = *(const f32x4*)(p + 4);
    return 1.0f / sqrtf(((a[0] + a[1]) + (a[2] + a[3]) + (b[0] + b[1]) + (b[2] + b[3])) * inv_n + RMS_EPS);
}
__device__ __forceinline__ float rstd_from16(const float* p, float inv_n) {
    const f32x4 a = *(const f32x4*)p, b = *(const f32x4*)(p + 4), c = *(const f32x4*)(p + 8), d = *(const f32x4*)(p + 12);
    return 1.0f / sqrtf((((a[0] + a[1]) + (a[2] + a[3])) + ((b[0] + b[1]) + (b[2] + b[3])) + ((c[0] + c[1]) + (c[2] + c[3])) + ((d[0] + d[1]) + (d[2] + d[3]))) * inv_n + RMS_EPS);
}

struct EpiOutProj {
    static constexpr bool PERM = true, AFTER_DRAIN = false, MIDK = true;
    const float* x; float* x1; unsigned short* x1h; const float* g1; const PG8_LAS float* rowf; float* ssx1;
    __device__ __forceinline__ void midk(f32x4 (&acc)[2][2][4][2], const Unit& u, int wr, int wc, int fr, int fq) const {
#pragma unroll
        for (int ai = 0; ai < 2; ++ai)
#pragma unroll
            for (int m = 0; m < 4; ++m) {
                const float f = rowf[2 * (ai * HALF + wr * 64 + m * 16 + fr)];
#pragma unroll
                for (int bj = 0; bj < 2; ++bj)
#pragma unroll
                    for (int n = 0; n < 2; ++n) acc[ai][bj][m][n] = acc[ai][bj][m][n] * f;
            }
    }
    __device__ __forceinline__ void operator()(const f32x4 (&acc)[2][2][4][2], const Unit& u, int wr, int wc, int fr, int fq) const {
#pragma unroll
        for (int ai = 0; ai < 2; ++ai)
#pragma unroll
            for (int m = 0; m < 4; ++m) {
                const int rl = ai * HALF + wr * 64 + m * 16 + fr, row = u.pm * BM + rl; const int b = row >> 13;
                const float rg = rowf[2 * rl + 1];
                float ss = 0.f;
#pragma unroll
                for (int bj = 0; bj < 2; ++bj) {
                    const int c0 = u.pn * BM + bj * HALF + wc * 32 + 8 * fq; const size_t off = (size_t)row * 1024 + c0;
                    const f32x4 x0 = *(const f32x4*)(x + off), x1v = *(const f32x4*)(x + off + 4);
                    const f32x4 g0 = *(const f32x4*)(g1 + b * 6144 + c0), g1v = *(const f32x4*)(g1 + b * 6144 + c0 + 4);
                    const f32x4 o0 = x0 + g0 * (acc[ai][bj][m][0] * rg), o1 = x1v + g1v * (acc[ai][bj][m][1] * rg);
                    *(f32x4*)(x1 + off) = o0; *(f32x4*)(x1 + off + 4) = o1;
                    u32x4 w; w.x = pk_f16(o0[0], o0[1]); w.y = pk_f16(o0[2], o0[3]); w.z = pk_f16(o1[0], o1[1]); w.w = pk_f16(o1[2], o1[3]);
                    *(u32x4*)(x1h + off) = w;
                    ss += (o0[0] * o0[0] + o0[1] * o0[1]) + (o0[2] * o0[2] + o0[3] * o0[3]) + (o1[0] * o1[0] + o1[1] * o1[1]) + (o1[2] * o1[2] + o1[3] * o1[3]);
                }
                ss += __shfl_xor(ss, 16); ss += __shfl_xor(ss, 32);
                if (fq == 0) ssx1[(size_t)row * 16 + u.pn * 4 + wc] = ss;
                asm volatile("" ::: "memory");
            }
    }
};
struct SingleOrder { Unit u; __device__ bool next(int i, Unit& o) const { if (i) return false; o = u; return true; }
    __device__ __forceinline__ void a_ready(const Unit&) const {} __device__ __forceinline__ void done(const Unit&) const {} };

struct EpiFF1 {
    static constexpr bool PERM = true, AFTER_DRAIN = false, MIDK = false;
    unsigned short* U; const float* bias1; const float* ssx1;
    __device__ __forceinline__ void midk(f32x4 (&)[2][2][4][2], const Unit&, int, int, int, int) const {}
    __device__ __forceinline__ void operator()(const f32x4 (&acc)[2][2][4][2], const Unit& u, int wr, int wc, int fr, int fq) const {
        const int b = u.pm >> 5;
        f32x4 bv[2][2];
#pragma unroll
        for (int bj = 0; bj < 2; ++bj)
#pragma unroll
            for (int n = 0; n < 2; ++n) bv[bj][n] = *(const f32x4*)(bias1 + b * 4096 + u.pn * BM + bj * HALF + wc * 32 + 8 * fq + 4 * n);
#pragma unroll
        for (int ai = 0; ai < 2; ++ai)
#pragma unroll
            for (int m = 0; m < 4; ++m) {
                const int row = u.pm * BM + ai * HALF + wr * 64 + m * 16 + fr;
                const float r2 = rstd_from16(ssx1 + (size_t)row * 16, 1.0f / 1024.0f);
#pragma unroll
                for (int bj = 0; bj < 2; ++bj) {
                    f32x4 z0 = acc[ai][bj][m][0] * r2 + bv[bj][0], z1 = acc[ai][bj][m][1] * r2 + bv[bj][1];
#pragma unroll
                    for (int j = 0; j < 4; ++j) { const float a = fmaxf(z0[j], 0.f), c = fmaxf(z1[j], 0.f); z0[j] = a * a; z1[j] = c * c; }
                    u32x4 w; w.x = pk_f16(z0[0], z0[1]); w.y = pk_f16(z0[2], z0[3]); w.z = pk_f16(z1[0], z1[1]); w.w = pk_f16(z1[2], z1[3]);
                    *(u32x4*)(U + (size_t)row * 4096 + u.pn * BM + bj * HALF + wc * 32 + 8 * fq) = w;
                }
            }
    }
};

struct EpiFF2 {
    static constexpr bool PERM = true, AFTER_DRAIN = false, MIDK = false;
    float* x1; const float* g2; float* ssx2;
    __device__ __forceinline__ void midk(f32x4 (&)[2][2][4][2], const Unit&, int, int, int, int) const {}
    __device__ __forceinline__ void operator()(const f32x4 (&acc)[2][2][4][2], const Unit& u, int wr, int wc, int fr, int fq) const {
#pragma unroll
        for (int ai = 0; ai < 2; ++ai)
#pragma unroll
            for (int m = 0; m < 4; ++m) {
                const int row = u.pm * BM + ai * HALF + wr * 64 + m * 16 + fr; const int b = row >> 13;
                float ss = 0.f;
#pragma unroll
                for (int bj = 0; bj < 2; ++bj) {
                    const int c0 = u.pn * BM + bj * HALF + wc * 32 + 8 * fq; const size_t off = (size_t)row * 1024 + c0;
                    const f32x4 x0 = *(const f32x4*)(x1 + off), x1v = *(const f32x4*)(x1 + off + 4);
                    const f32x4 g0 = *(const f32x4*)(g2 + b * 6144 + c0), g1v = *(const f32x4*)(g2 + b * 6144 + c0 + 4);
                    const f32x4 o0 = x0 + g0 * acc[ai][bj][m][0], o1 = x1v + g1v * acc[ai][bj][m][1];
                    *(f32x4*)(x1 + off) = o0; *(f32x4*)(x1 + off + 4) = o1;
                    ss += (o0[0] * o0[0] + o0[1] * o0[1]) + (o0[2] * o0[2] + o0[3] * o0[3]) + (o1[0] * o1[0] + o1[1] * o1[1]) + (o1[2] * o1[2] + o1[3] * o1[3]);
                }
                ss += __shfl_xor(ss, 16); ss += __shfl_xor(ss, 32);
                if (fq == 0) ssx2[(size_t)row * 16 + u.pn * 4 + wc] = ss;
            }
    }
};


template <class Epi, class Sched, bool ALIGN_EPI = false, bool SP2 = false>
__device__ __forceinline__ void gemm_phase(PG8_LAS unsigned char* lds, const Gemm g, const Sched& S, const Epi& E) {
    const int tid = threadIdx.x, wid = __builtin_amdgcn_readfirstlane(tid >> 6), lane = tid & 63, wr = wid >> 2, wc = wid & 3, fr = lane & 15, fq = lane >> 4;
    const int K = g.K, nt = K / BK;
    unsigned voffA[2], voffB[2];
#pragma unroll
    for (int i = 0; i < 2; ++i) { int R, C; stage_rc(tid * 16 + i * 8192, R, C); const int Rb = Epi::PERM ? ((R & ~31) + perm32(R & 31)) : R;
        voffA[i] = (unsigned)(R * K + C) * 2u; voffB[i] = (unsigned)(Rb * K + C) * 2u; }
    const size_t kstep = (size_t)(BK * 2);
    const size_t hstep = (size_t)HALF * K * 2;
    const size_t tstep = 2 * hstep;
    const unsigned ldsw = (unsigned)wid * 1024u;
    const int aoff = lds_byte(wr * 64 + fr, fq * 8), boff = lds_byte(wc * 32 + fr, fq * 8);
#define PG8_SA(b, h) (((b) * 2 + (h)) * HTB)
#define PG8_SB(b, h) ((4 + (b) * 2 + (h)) * HTB)
#define PG8_STAGE(bufoff, gbase, voff) do { _Pragma("unroll") for (int _i = 0; _i < 2; ++_i) \
        __builtin_amdgcn_global_load_lds((const unsigned*)((const char*)(gbase) + (voff)[_i]), (PG8_LAS unsigned*)(lds + (bufoff) + ldsw + _i * 8192), 16, 0, 0); } while (0)
#define PG8_LDA(dst, b, h) do { _Pragma("unroll") for (int m = 0; m < 4; ++m) _Pragma("unroll") for (int k = 0; k < 2; ++k) dst[m][k] = *(const PG8_LAS bf16x8*)(lds + PG8_SA(b, h) + aoff + m * 2048 + k * 1024); } while (0)
#define PG8_LDB(dst, b, h) do { _Pragma("unroll") for (int n = 0; n < 2; ++n) _Pragma("unroll") for (int k = 0; k < 2; ++k) dst[n][k] = *(const PG8_LAS bf16x8*)(lds + PG8_SB(b, h) + boff + n * 2048 + k * 1024); } while (0)
#define PG8_MMA(ai, bj, At, Bt) do { __builtin_amdgcn_s_setprio(1); _Pragma("unroll") for (int m = 0; m < 4; ++m) _Pragma("unroll") for (int n = 0; n < 2; ++n) _Pragma("unroll") for (int k = 0; k < 2; ++k) \
        acc[ai][bj][m][n] = __builtin_amdgcn_mfma_f32_16x16x32_f16(__builtin_bit_cast(f16x8, Bt[n][k]), __builtin_bit_cast(f16x8, At[m][k]), acc[ai][bj][m][n], 0, 0, 0); __builtin_amdgcn_s_setprio(0); } while (0)
#define PG8_WAIT_V(n) asm volatile("s_waitcnt vmcnt(" #n ")" ::: "memory")
#define PG8_WAIT_L(n) asm volatile("s_waitcnt lgkmcnt(" #n ")" ::: "memory")
#define PG8_BAR __builtin_amdgcn_s_barrier()
#define PG8_SCHED __builtin_amdgcn_sched_barrier(0)
    Unit cur, nxt; int ui = 0;
    if (!S.next(0, cur)) return;
    f32x4 acc[2][2][4][2];
#pragma unroll
    for (int a = 0; a < 2; ++a)
#pragma unroll
        for (int b = 0; b < 2; ++b)
#pragma unroll
            for (int m = 0; m < 4; ++m)
#pragma unroll
                for (int n = 0; n < 2; ++n) acc[a][b][m][n] = (f32x4){0.f, 0.f, 0.f, 0.f};
    bf16x8 At[4][2], B0[2][2], B1[2][2];
    const char* cA = (const char*)g.A + (size_t)cur.pm * tstep; const char* cB = (const char*)g.Bt + (size_t)cur.pn * tstep + (size_t)(cur.pm >> 5) * g.bbatch;
    S.a_ready(cur);
    if constexpr (SP2) {
        PG8_STAGE(PG8_SB(0, 0), cB, voffB); PG8_STAGE(PG8_SB(0, 1), cB + hstep, voffB); PG8_STAGE(PG8_SA(0, 0), cA, voffA); PG8_STAGE(PG8_SA(0, 1), cA + hstep, voffA);
        if (wr == 1) PG8_BAR;
        PG8_WAIT_V(2); PG8_BAR;
        PG8_STAGE(PG8_SB(1, 0), cB + kstep, voffB); PG8_STAGE(PG8_SA(1, 0), cA + kstep, voffA); PG8_STAGE(PG8_SB(1, 1), cB + hstep + kstep, voffB);
        PG8_WAIT_V(6); PG8_BAR;
    } else {
        PG8_STAGE(PG8_SB(0, 0), cB, voffB); PG8_STAGE(PG8_SA(0, 0), cA, voffA); PG8_STAGE(PG8_SB(0, 1), cB + hstep, voffB); PG8_STAGE(PG8_SA(0, 1), cA + hstep, voffA);
        if (wr == 1) PG8_BAR;
        PG8_WAIT_V(4); PG8_BAR;
        PG8_STAGE(PG8_SB(1, 0), cB + kstep, voffB); PG8_STAGE(PG8_SA(1, 0), cA + kstep, voffA); PG8_STAGE(PG8_SB(1, 1), cB + hstep + kstep, voffB);
        PG8_WAIT_V(6); PG8_BAR;
    }
    for (;;) {
        const bool has_next = S.next(ui + 1, nxt);
        const char* nA = has_next ? (const char*)g.A + (size_t)nxt.pm * tstep : cA; const char* nB = has_next ? (const char*)g.Bt + (size_t)nxt.pn * tstep + (size_t)(nxt.pm >> 5) * g.bbatch : cB;
        for (int t = 0; t < nt; t += 2) {
            if constexpr (Epi::MIDK) { if (t == (nt >> 1)) E.midk(acc, cur, wr, wc, fr, fq); }
            const bool last = (t == nt - 2);
            const char* a1 = cA + (size_t)(t + 1) * kstep;
            const char* a2 = last ? nA : cA + (size_t)(t + 2) * kstep; const char* b2 = last ? nB : cB + (size_t)(t + 2) * kstep;
            const char* a3 = a2 + kstep; const char* b3 = b2 + kstep;
            if (last && has_next) S.a_ready(nxt);
            if constexpr (SP2) {
            PG8_LDB(B0, 0, 0); PG8_LDB(B1, 0, 1); PG8_SCHED; PG8_LDA(At, 0, 0); PG8_STAGE(PG8_SA(1, 1), a1 + hstep, voffA);
            PG8_WAIT_V(8); PG8_WAIT_L(0); PG8_BAR; PG8_MMA(0, 0, At, B0); PG8_MMA(0, 1, At, B1); PG8_BAR; PG8_SCHED;
            PG8_LDA(At, 0, 1); PG8_STAGE(PG8_SB(0, 0), b2, voffB); PG8_STAGE(PG8_SB(0, 1), b2 + hstep, voffB); PG8_STAGE(PG8_SA(0, 0), a2, voffA);
            PG8_WAIT_V(8); PG8_WAIT_L(0); PG8_BAR; PG8_MMA(1, 0, At, B0); PG8_MMA(1, 1, At, B1); PG8_BAR; PG8_SCHED;
            PG8_LDB(B0, 1, 0); PG8_LDB(B1, 1, 1); PG8_SCHED; PG8_LDA(At, 1, 0); PG8_STAGE(PG8_SA(0, 1), a2 + hstep, voffA);
            PG8_WAIT_V(8); PG8_WAIT_L(0); PG8_BAR; PG8_MMA(0, 0, At, B0); PG8_MMA(0, 1, At, B1); PG8_BAR; PG8_SCHED;
            PG8_LDA(At, 1, 1); PG8_STAGE(PG8_SB(1, 0), b3, voffB); PG8_STAGE(PG8_SB(1, 1), b3 + hstep, voffB); PG8_STAGE(PG8_SA(1, 0), a3, voffA);
            PG8_WAIT_V(8); PG8_WAIT_L(0); PG8_BAR; PG8_MMA(1, 0, At, B0); PG8_MMA(1, 1, At, B1); PG8_BAR; PG8_SCHED;
            } else {
            PG8_LDB(B0, 0, 0); PG8_SCHED; PG8_LDA(At, 0, 0); PG8_STAGE(PG8_SA(1, 1), a1 + hstep, voffA);
            PG8_WAIT_L(8); PG8_BAR; PG8_WAIT_L(0); PG8_MMA(0, 0, At, B0); PG8_BAR; PG8_SCHED;
            PG8_LDB(B1, 0, 1); PG8_STAGE(PG8_SB(0, 0), b2, voffB);
            PG8_BAR; PG8_WAIT_L(0); PG8_MMA(0, 1, At, B1); PG8_BAR;
            PG8_LDA(At, 0, 1); PG8_STAGE(PG8_SA(0, 0), a2, voffA);
            PG8_BAR; PG8_WAIT_L(0); PG8_MMA(1, 0, At, B0); PG8_BAR; PG8_SCHED;
            PG8_STAGE(PG8_SB(0, 1), b2 + hstep, voffB);
            PG8_WAIT_V(6); PG8_BAR; PG8_MMA(1, 1, At, B1); PG8_BAR;
            PG8_LDB(B0, 1, 0); PG8_SCHED; PG8_LDA(At, 1, 0); PG8_STAGE(PG8_SA(0, 1), a2 + hstep, voffA);
            PG8_WAIT_L(8); PG8_BAR; PG8_WAIT_L(0); PG8_MMA(0, 0, At, B0); PG8_BAR; PG8_SCHED;
            PG8_LDB(B1, 1, 1); PG8_STAGE(PG8_SB(1, 0), b3, voffB);
            PG8_BAR; PG8_WAIT_L(0); PG8_MMA(0, 1, At, B1); PG8_BAR;
            PG8_LDA(At, 1, 1); PG8_STAGE(PG8_SA(1, 0), a3, voffA);
            PG8_BAR; PG8_WAIT_L(0); PG8_MMA(1, 0, At, B0); PG8_BAR; PG8_SCHED;
            PG8_STAGE(PG8_SB(1, 1), b3 + hstep, voffB);
            PG8_WAIT_V(6); PG8_BAR; PG8_MMA(1, 1, At, B1); PG8_BAR;
            }
        }
        if constexpr (ALIGN_EPI) { if (wr == 0) PG8_BAR; }
        if constexpr (!Epi::AFTER_DRAIN) { E(acc, cur, wr, wc, fr, fq); S.done(cur); }
        if (!has_next) break;
#pragma unroll
        for (int a = 0; a < 2; ++a)
#pragma unroll
            for (int b = 0; b < 2; ++b)
#pragma unroll
                for (int m = 0; m < 4; ++m)
#pragma unroll
                    for (int n = 0; n < 2; ++n) acc[a][b][m][n] = (f32x4){0.f, 0.f, 0.f, 0.f};
        cur = nxt; cA = nA; cB = nB; ++ui;
        if constexpr (ALIGN_EPI) { if (wr == 1) PG8_BAR; }
    }
    PG8_WAIT_V(0);
    if constexpr (!ALIGN_EPI) { if (wr == 0) PG8_BAR; }
    PG8_BAR;
    if constexpr (Epi::AFTER_DRAIN) { E.fused(acc, cur, wr, wc, fr, fq, lds, wid, lane); S.done(cur); }
#undef PG8_SA
#undef PG8_SB
#undef PG8_STAGE
#undef PG8_LDA
#undef PG8_LDB
#undef PG8_MMA
#undef PG8_WAIT_V
#undef PG8_WAIT_L
#undef PG8_BAR
#undef PG8_SCHED
}
}
#include <hip/hip_bf16.h>
#include <cmath>
namespace attn_body {
using bf16=__hip_bfloat16;
using bf16x8=__attribute__((ext_vector_type(8)))short;
using s16x4=__attribute__((ext_vector_type(4)))short;
using f32x16=__attribute__((ext_vector_type(16)))float;
using u32x4=__attribute__((ext_vector_type(4)))unsigned;
constexpr int BATCH=2,NHEAD=8,SEQ=8192,D=64,DM=NHEAD*D,OPITCH=1024;
constexpr int NW=8,QBLK=32,QB=QBLK*NW,KVBLK=64,NQB=SEQ/QB;
constexpr int ATTN_PITCH=DM, ATTN_UNIT_ROWS=QB;
__device__ __forceinline__ int crow(int r,int hi){return (r&3)+8*(r>>2)+4*hi;}
#define SBAR() __builtin_amdgcn_sched_barrier(0)
__device__ __forceinline__ void cmask(f32x16&p0,f32x16&p1,int jb,int qrel,int hi){
  const float NEG=-INFINITY; int kb=64*jb+4*hi;
  #pragma unroll
  for(int r=0;r<16;++r){int kv=kb+(r&3)+8*(r>>2); if(kv>qrel)p0[r]=NEG; if(kv+32>qrel)p1[r]=NEG;}
}

constexpr int NSLOT=3, SLOTB=8192;
constexpr int LDS_K=0, LDS_V=NSLOT*SLOTB, LDS_WS=2*NSLOT*SLOTB, LDS_OST=LDS_WS+NW*64*4, LDS_BYTES=LDS_OST+NW*4096;
constexpr float C2=0.125f*1.4426950408889634f;
__device__ __forceinline__ void glds16(const void*gsrc,unsigned lds_dst){unsigned keep;
  asm volatile("s_mov_b32 %0, m0\n\ts_mov_b32 m0, %2\n\ts_nop 0\n\tglobal_load_lds_dwordx4 %1, off\n\ts_mov_b32 m0, %0":"=&s"(keep):"v"(gsrc),"s"(lds_dst):"memory");}
__device__ __forceinline__ float max3f(float a,float b,float c){float r;asm("v_max3_f32 %0, %1, %2, %3":"=v"(r):"v"(a),"v"(b),"v"(c));return r;}
__device__ __forceinline__ float max2f(float a,float b){float r;asm("v_max_f32_e32 %0, %1, %2":"=v"(r):"v"(a),"v"(b));return r;}
__device__ __forceinline__ float fadd_s(float a,float b){float r;asm("v_add_f32_e32 %0, %1, %2":"=v"(r):"v"(a),"v"(b));return r;}
__device__ __forceinline__ float fsub_s(float a,float b){float r;asm("v_sub_f32_e32 %0, %1, %2":"=v"(r):"v"(a),"v"(b));return r;}
typedef float f32x2_t __attribute__((ext_vector_type(2))); typedef __bf16 bf16x2_t __attribute__((ext_vector_type(2)));
__device__ __forceinline__ unsigned cvtpk_s(float lo,float hi){f32x2_t v={lo,hi};bf16x2_t b=__builtin_convertvector(v,bf16x2_t);return __builtin_bit_cast(unsigned,b);}
#define WAIT_BAR(N) asm volatile("s_waitcnt vmcnt(" #N ") lgkmcnt(0)\n\ts_barrier":::"memory")

__device__ __forceinline__ void qkt(f32x16&p0,f32x16&p1,const char*Kslot,const bf16x8*qr,const f32x16&negm,int r32,int hi){
  const char*kb=Kslot+hi*1024+r32*16;
  #pragma unroll
  for(int d0=0;d0<4;++d0){
    const bf16x8 b0=*reinterpret_cast<const bf16x8*>(kb+d0*2048);
    const bf16x8 b1=*reinterpret_cast<const bf16x8*>(kb+d0*2048+512);
    if(d0==0){p0=__builtin_amdgcn_mfma_f32_32x32x16_bf16(b0,qr[0],negm,0,0,0);p1=__builtin_amdgcn_mfma_f32_32x32x16_bf16(b1,qr[0],negm,0,0,0);}
    else{p0=__builtin_amdgcn_mfma_f32_32x32x16_bf16(b0,qr[d0],p0,0,0,0);p1=__builtin_amdgcn_mfma_f32_32x32x16_bf16(b1,qr[d0],p1,0,0,0);}}
}
typedef __attribute__((address_space(3))) const char* lds_cptr;
typedef short v4i16_t __attribute__((ext_vector_type(4)));
__device__ __forceinline__ void kload8(bf16x8*kf,lds_cptr kp){
  kf[0]=*(const __attribute__((address_space(3))) bf16x8*)(kp);      kf[1]=*(const __attribute__((address_space(3))) bf16x8*)(kp+512);
  kf[2]=*(const __attribute__((address_space(3))) bf16x8*)(kp+2048); kf[3]=*(const __attribute__((address_space(3))) bf16x8*)(kp+2560);
  kf[4]=*(const __attribute__((address_space(3))) bf16x8*)(kp+4096); kf[5]=*(const __attribute__((address_space(3))) bf16x8*)(kp+4608);
  kf[6]=*(const __attribute__((address_space(3))) bf16x8*)(kp+6144); kf[7]=*(const __attribute__((address_space(3))) bf16x8*)(kp+6656);
}
__device__ __forceinline__ void kload2(bf16x8*kf,lds_cptr kp,int j){ kf[2*j]=*(const __attribute__((address_space(3))) bf16x8*)(kp+j*2048); kf[2*j+1]=*(const __attribute__((address_space(3))) bf16x8*)(kp+j*2048+512); }
__device__ __forceinline__ s16x4 vtr(lds_cptr p){ return __builtin_bit_cast(s16x4,__builtin_amdgcn_ds_read_tr16_b64_v4i16((__attribute__((address_space(3))) v4i16_t*)p)); }
__device__ __forceinline__ float rowmax(const f32x16&p0,const f32x16&p1){
  float a=max3f(p0[0],p0[1],p1[0]),b=max3f(p0[2],p0[3],p1[1]);a=max3f(a,p1[2],p1[3]);
  #pragma unroll
  for(int r=4;r<16;r+=4){a=max3f(a,p0[r],p0[r+1]);b=max3f(b,p0[r+2],p0[r+3]);a=max3f(a,p1[r],p1[r+1]);b=max3f(b,p1[r+2],p1[r+3]);}
  const float m=max2f(a,b);
  auto rr=__builtin_amdgcn_permlane32_swap(__float_as_uint(m),__float_as_uint(m),false,false);
  return max2f(__uint_as_float(rr[0]),__uint_as_float(rr[1]));
}
__device__ __forceinline__ void pv(f32x16*o,int vb,bf16x8 pa0,bf16x8 pa1,bf16x8 pa2,bf16x8 pa3){
  #pragma unroll
  for(int d0=0;d0<2;++d0){s16x4 lo[4],hi[4];
    #pragma unroll
    for(int ks=0;ks<4;++ks){
      asm volatile("ds_read_b64_tr_b16 %0,%1 offset:%c2":"=&v"(lo[ks]):"v"(vb),"i"(d0*4096+ks*1024):"memory");
      asm volatile("ds_read_b64_tr_b16 %0,%1 offset:%c2":"=&v"(hi[ks]):"v"(vb),"i"(d0*4096+ks*1024+512):"memory");}
    asm volatile("s_waitcnt lgkmcnt(0)":::"memory");SBAR();
    #define PK(k) (bf16x8){lo[k][0],lo[k][1],lo[k][2],lo[k][3],hi[k][0],hi[k][1],hi[k][2],hi[k][3]}
    o[d0]=__builtin_amdgcn_mfma_f32_32x32x16_bf16(pa0,PK(0),o[d0],0,0,0);
    o[d0]=__builtin_amdgcn_mfma_f32_32x32x16_bf16(pa1,PK(1),o[d0],0,0,0);
    o[d0]=__builtin_amdgcn_mfma_f32_32x32x16_bf16(pa2,PK(2),o[d0],0,0,0);
    o[d0]=__builtin_amdgcn_mfma_f32_32x32x16_bf16(pa3,PK(3),o[d0],0,0,0);
    #undef PK
  }
}

#ifndef ATTN_STORE16
#define ATTN_STORE16(p,v) (*(u32x4*)(p)=(v))
#endif
__device__ __forceinline__ float mskf(float v,unsigned w,int bit){ return __uint_as_float(__float_as_uint(v)&(unsigned)(((int)(w<<(31-bit)))>>31)); }
#define WAIT_BARM(N,R) asm volatile("s_waitcnt vmcnt(" #N ") lgkmcnt(0)\n\ts_barrier":"+v"(R)::"memory")
template<int THRL> __device__ __forceinline__ void attn_unit(int b,int h,int qb,const bf16*Q,const bf16*__restrict__ K,const bf16*__restrict__ V,unsigned short*O,const unsigned*MV,float*SSA,char*shm){
  const int tid=threadIdx.x,lane=tid&63,r32=lane&31,hi=lane>>5; const int wid=__builtin_amdgcn_readfirstlane(tid>>6);
  const long rowbase=(long)b*SEQ; const int q0=qb*QB;
  const bf16*Qw=Q+(rowbase+q0+wid*QBLK)*DM+h*D;
  const bf16*Kh=K+rowbase*DM+h*D,*Vh=V+rowbase*DM+h*D;
  const unsigned lds0=(unsigned)(uintptr_t)shm;
  float*wsf=(float*)(shm+LDS_WS)+wid*64;
  const bf16*ksrc=Kh+(long)lane*DM+wid*8;
  const bf16*vsrc=Vh+(long)(16*(wid&3)+(lane>>2))*DM+(wid>>2)*32+(lane&3)*8;
  const unsigned kdst=lds0+LDS_K+wid*1024, vdst=lds0+LDS_V+wid*1024;
  #define DMA_K(t,slot) glds16(ksrc+(long)(t)*KVBLK*DM,(unsigned)__builtin_amdgcn_readfirstlane(kdst+(slot)))
  #define DMA_V(t,slot) glds16(vsrc+(long)(t)*KVBLK*DM,(unsigned)__builtin_amdgcn_readfirstlane(vdst+(slot)))
  const int vb0=(int)(lds0+LDS_V)+((lane>>4)&1)*32+(lane&3)*8+(4*hi+((lane&15)>>2))*64;
  const char*Kbase=shm+LDS_K; bf16x8 kf[8];
  const lds_cptr shm3=(lds_cptr)shm; const lds_cptr kp0=shm3+LDS_K+hi*1024+r32*16; const lds_cptr vp0=shm3+LDS_V+((lane>>4)&1)*32+(lane&3)*8+(4*hi+((lane&15)>>2))*64;
  const int NT=(q0+QB)/KVBLK;
  DMA_K(0,0);DMA_V(0,0);DMA_K(1,SLOTB);
  bf16x8 qr[4];
  #pragma unroll
  for(int d0=0;d0<4;++d0)qr[d0]=*reinterpret_cast<const bf16x8*>(&Qw[(long)r32*DM+d0*16+hi*8]);
  float mhat=0.f,l_reg=0.f;f32x16 o[2];o[0]=f32x16{};o[1]=f32x16{};f32x16 negm=f32x16{};asm volatile("":"+v"(negm));
  const unsigned*mwb; { const unsigned long long pb_=(unsigned long long)(MV+((size_t)((b*256+(q0>>5)+wid)*128))*64); mwb=(const unsigned*)(((unsigned long long)(unsigned)__builtin_amdgcn_readfirstlane((int)(pb_>>32))<<32)|(unsigned)__builtin_amdgcn_readfirstlane((int)pb_)); }
  unsigned mwc=mwb[lane],mwn=0u;
  #define CMASK(P0,P1,t) do{}while(0)
  bool resc=false;
  #define START(P0,P1) do{ const float rm=rowmax(P0,P1); resc=false; \
    { const float dl=rm; mhat=fadd_s(mhat,dl); \
      _Pragma("unroll") for(int r=0;r<16;++r){P0[r]=fsub_s(P0[r],dl);P1[r]=fsub_s(P1[r],dl);} \
      _Pragma("unroll") for(int r=0;r<16;++r)negm[r]=-mhat; asm volatile("":"+v"(negm)); } \
    _Pragma("unroll") for(int r=0;r<16;++r)P0[r]=mskf(__builtin_amdgcn_exp2f(P0[r]),mwc,r); }while(0)
  #define RESC() do{ if(resc){ asm volatile("s_waitcnt lgkmcnt(0)":::"memory"); \
      _Pragma("unroll") for(int d_=0;d_<2;++d_) _Pragma("unroll") for(int r=0;r<16;++r)o[d_][r]*=wsf[crow(r,hi)]; } }while(0)
  f32x16 pA0,pA1,pB0,pB1;
  int sl_prev=0,sl_cur=0,sl_next=SLOTB;
  #define ROT() do{sl_prev=sl_cur;sl_cur=sl_next;sl_next=(sl_next==(NSLOT-1)*SLOTB)?0:sl_next+SLOTB;}while(0)
  DMA_K(2,2*SLOTB);
  WAIT_BAR(3);
  qkt(pA0,pA1,Kbase,qr,negm,r32,hi);asm volatile("s_nop 15\n\ts_nop 7":"+v"(pA0),"+v"(pA1));CMASK(pA0,pA1,0);
  START(pA0,pA1);
  _Pragma("unroll") for(int r=0;r<16;++r)pA1[r]=mskf(__builtin_amdgcn_exp2f(pA1[r]),mwc,16+r);
  WAIT_BAR(0);
  { const unsigned*mp_=mwb+64; const unsigned l4_=(unsigned)lane*4u; asm volatile("global_load_dword %0, %1, %2":"=v"(mwn):"v"(l4_),"s"(mp_):"memory"); }
  DMA_K(3,0);DMA_V(1,SLOTB);
  ROT();
  kload8(kf,kp0+sl_cur);
  WAIT_BARM(2,mwn); mwc=mwn;
  s16x4 vlo[8],vhi[8]; u32x4 pw0,pw1,pw2,pw3;
  #define PKW(P,B) cvtpk_s(P[B],P[B+1])
  #define PAF(k) __builtin_bit_cast(bf16x8,pw##k)
  #define VFR(i) (bf16x8){vlo[i][0],vlo[i][1],vlo[i][2],vlo[i][3],vhi[i][0],vhi[i][1],vhi[i][2],vhi[i][3]}
  #define PIN(x) asm volatile("":"+v"(x))
  #define MX3(a,b,c) __builtin_fmaxf(__builtin_fmaxf((a),(b)),(c))
  #define GAPA(MF,A0,A1,A2,A3,W0,W1,PW) do{ MF; sacc+=A0; sacc+=A1; sacc+=A2; sacc+=A3; PIN(sacc); W0; W1; PIN(PW); SBAR(); }while(0)
  #define EX(v) __builtin_amdgcn_exp2f(v)
  #define GAPB(MF,X,B,MB) do{ MF; X[B]=mskf(EX(X[B]),mwc_,MB+B); X[B+1]=mskf(EX(X[B+1]),mwc_,MB+B+1); X[B+2]=mskf(EX(X[B+2]),mwc_,MB+B+2); X[B+3]=mskf(EX(X[B+3]),mwc_,MB+B+3); PIN(X); SBAR(); }while(0)
  #define VRD(i) do{ vlo[i]=vtr(vp_+(((i)>>2)*4096+((i)&3)*1024)); vhi[i]=vtr(vp_+(((i)>>2)*4096+((i)&3)*1024+512)); }while(0)
  #define KRD(G,j) do{ if(G){ kload2(kf,kp0+sl_next,j); SBAR(); } }while(0)
  #define STEP(C0,C1,P0,P1,t,GK,GV,GL,GM) do{ SBAR(); \
    if(GM){ const unsigned*mp_=mwb+(size_t)((t)+1)*64; const unsigned l4_=(unsigned)lane*4u; asm volatile("global_load_dword %0, %1, %2":"=v"(mwn):"v"(l4_),"s"(mp_):"memory"); } const unsigned mwc_=mwc; \
    const lds_cptr vp_=vp0+sl_prev; \
    VRD(0); SBAR(); float sacc=(P0[0]+P0[1]); \
    GAPA(C0=__builtin_amdgcn_mfma_f32_32x32x16_bf16(kf[0],qr[0],negm,0,0,0), P0[2],P0[3],P0[4],P0[5],     pw0[0]=PKW(P0,0), pw0[1]=PKW(P0,2), pw0); \
    VRD(4); SBAR(); GAPA(C1=__builtin_amdgcn_mfma_f32_32x32x16_bf16(kf[1],qr[0],negm,0,0,0), P0[6],P0[7],P0[8],P0[9],     pw0[2]=PKW(P0,4), pw0[3]=PKW(P0,6), pw0); \
    VRD(1); SBAR(); GAPA(C0=__builtin_amdgcn_mfma_f32_32x32x16_bf16(kf[2],qr[1],C0,0,0,0),   P0[10],P0[11],P0[12],P0[13], pw1[0]=PKW(P0,8), pw1[1]=PKW(P0,10), pw1); \
    VRD(5); SBAR(); GAPA(C1=__builtin_amdgcn_mfma_f32_32x32x16_bf16(kf[3],qr[1],C1,0,0,0),   P0[14],P0[15],P1[0],P1[1],   pw1[2]=PKW(P0,12),pw1[3]=PKW(P0,14), pw1); \
    VRD(2); SBAR(); GAPA(C0=__builtin_amdgcn_mfma_f32_32x32x16_bf16(kf[4],qr[2],C0,0,0,0),   P1[2],P1[3],P1[4],P1[5],     pw2[0]=PKW(P1,0), pw2[1]=PKW(P1,2), pw2); \
    VRD(6); SBAR(); GAPA(C1=__builtin_amdgcn_mfma_f32_32x32x16_bf16(kf[5],qr[2],C1,0,0,0),   P1[6],P1[7],P1[8],P1[9],     pw2[2]=PKW(P1,4), pw2[3]=PKW(P1,6), pw2); \
    VRD(3); SBAR(); GAPA(C0=__builtin_amdgcn_mfma_f32_32x32x16_bf16(kf[6],qr[3],C0,0,0,0),   P1[10],P1[11],P1[12],P1[13], pw3[0]=PKW(P1,8), pw3[1]=PKW(P1,10), pw3); \
    VRD(7); SBAR(); GAPA(C1=__builtin_amdgcn_mfma_f32_32x32x16_bf16(kf[7],qr[3],C1,0,0,0),   P1[14],P1[15],0.f,0.f,       pw3[2]=PKW(P1,12),pw3[3]=PKW(P1,14), pw3); \
    l_reg+=sacc; \
    if(GK){DMA_K((t)+3,sl_cur);} if(GV){DMA_V((t)+1,sl_next);} \
    CMASK(C0,C1,t); \
    { float a=MX3(C0[0],C0[1],C1[0]),b=MX3(C0[2],C0[3],C1[1]); a=MX3(a,C1[2],C1[3]); \
      _Pragma("unroll") for(int r=4;r<16;r+=4){a=MX3(a,C0[r],C0[r+1]);b=MX3(b,C0[r+2],C0[r+3]);a=MX3(a,C1[r],C1[r+1]);b=MX3(b,C1[r+2],C1[r+3]);} \
      float rm=__builtin_fmaxf(a,b); { auto rr=__builtin_amdgcn_permlane32_swap(__float_as_uint(rm),__float_as_uint(rm),false,false); rm=__builtin_fmaxf(__uint_as_float(rr[0]),__uint_as_float(rr[1])); } \
      resc=false; \
      if(__builtin_expect(__any(rm>(float)THRL),0)){ const float dl=__builtin_fmaxf(rm,0.f); mhat+=dl; \
        _Pragma("unroll") for(int r=0;r<16;++r){C0[r]-=dl;C1[r]-=dl;} \
        _Pragma("unroll") for(int r=0;r<16;++r)negm[r]=-mhat; asm volatile("":"+v"(negm)); \
        const float f=__builtin_amdgcn_exp2f(-dl); l_reg*=f; if(hi==0)wsf[r32]=f; resc=true; } } \
    SBAR(); \
    GAPB(o[0]=__builtin_amdgcn_mfma_f32_32x32x16_bf16(PAF(0),VFR(0),o[0],0,0,0), C0,0,0); \
    GAPB(o[1]=__builtin_amdgcn_mfma_f32_32x32x16_bf16(PAF(0),VFR(4),o[1],0,0,0), C0,4,0); \
    KRD(GL,0); GAPB(o[0]=__builtin_amdgcn_mfma_f32_32x32x16_bf16(PAF(1),VFR(1),o[0],0,0,0), C0,8,0); \
    KRD(GL,1); GAPB(o[1]=__builtin_amdgcn_mfma_f32_32x32x16_bf16(PAF(1),VFR(5),o[1],0,0,0), C0,12,0); \
    KRD(GL,2); GAPB(o[0]=__builtin_amdgcn_mfma_f32_32x32x16_bf16(PAF(2),VFR(2),o[0],0,0,0), C1,0,16); \
    KRD(GL,3); GAPB(o[1]=__builtin_amdgcn_mfma_f32_32x32x16_bf16(PAF(2),VFR(6),o[1],0,0,0), C1,4,16); \
    GAPB(o[0]=__builtin_amdgcn_mfma_f32_32x32x16_bf16(PAF(3),VFR(3),o[0],0,0,0), C1,8,16); \
    GAPB(o[1]=__builtin_amdgcn_mfma_f32_32x32x16_bf16(PAF(3),VFR(7),o[1],0,0,0), C1,12,16); \
    }while(0)
  int t=1;
  #undef CMASK
  #define CMASK(P0,P1,t) do{}while(0)
  for(;t+5<NT;t+=2){
    STEP(pB0,pB1,pA0,pA1,t,true,true,true,true);     WAIT_BARM(2,mwn); mwc=mwn; RESC(); ROT();
    STEP(pA0,pA1,pB0,pB1,t+1,true,true,true,true);   WAIT_BARM(2,mwn); mwc=mwn; RESC(); ROT();
  }
  #undef CMASK
  #define CMASK(P0,P1,t) do{}while(0)
  #define ENDW(tt) do{ if((tt)+3<NT){WAIT_BARM(2,mwn);} else if((tt)+2<NT){WAIT_BARM(1,mwn);} else {WAIT_BARM(0,mwn);} mwc=mwn; }while(0)
  for(;t+1<NT;t+=2){
    STEP(pB0,pB1,pA0,pA1,t,(t+3<NT),(t+1<NT),(t+1<NT),true);       ENDW(t);   RESC(); ROT();
    STEP(pA0,pA1,pB0,pB1,t+1,(t+4<NT),(t+2<NT),(t+2<NT),true);     ENDW(t+1); RESC(); ROT();
  }
  STEP(pB0,pB1,pA0,pA1,NT-1,false,false,false,false); RESC();
  { float sacc=pB0[0]+pB0[1]; _Pragma("unroll") for(int r=2;r<16;++r)sacc+=pB0[r]; _Pragma("unroll") for(int r=0;r<16;++r)sacc+=pB1[r]; l_reg+=sacc;
    pw0=(u32x4){PKW(pB0,0),PKW(pB0,2),PKW(pB0,4),PKW(pB0,6)};pw1=(u32x4){PKW(pB0,8),PKW(pB0,10),PKW(pB0,12),PKW(pB0,14)};pw2=(u32x4){PKW(pB1,0),PKW(pB1,2),PKW(pB1,4),PKW(pB1,6)};pw3=(u32x4){PKW(pB1,8),PKW(pB1,10),PKW(pB1,12),PKW(pB1,14)};
    SBAR(); pv(o,vb0+sl_cur,PAF(0),PAF(1),PAF(2),PAF(3)); }
  #undef PKW
  #undef PAF
  #undef VFR
  #undef PIN
  #undef MX3
  #undef GAPA
  #undef GAPB
  #undef EX
  #undef VRD
  #undef KRD
  #undef STEP
  #undef ENDW
  {auto rr=__builtin_amdgcn_permlane32_swap(__float_as_uint(l_reg),__float_as_uint(l_reg),false,false);l_reg=__uint_as_float(rr[0])+__uint_as_float(rr[1]);}
  if(hi==0)wsf[32+r32]=l_reg;asm volatile("s_waitcnt lgkmcnt(0)":::"memory");
  float rli[16];
  #pragma unroll
  for(int r=0;r<16;++r)rli[r]=__builtin_amdgcn_rcpf(wsf[32+crow(r,hi)]);
  unsigned short*Ow=O+(rowbase+q0+wid*QBLK)*(long)OPITCH+h*D; float*SSw=SSA+(rowbase+q0+wid*QBLK)*8+h;
  { _Float16*stg=(_Float16*)(shm+LDS_OST)+wid*2048;
    #pragma unroll
    for(int r=0;r<16;++r){const int orow=crow(r,hi);
      #pragma unroll
      for(int d0=0;d0<2;++d0)stg[orow*64+d0*32+r32]=(_Float16)(o[d0][r]*rli[r]);}
    asm volatile("s_waitcnt lgkmcnt(0)":::"memory");
    int ln2=lane; asm volatile("":"+v"(ln2));
    #pragma unroll
    for(int i=0;i<4;++i){const int row=i*8+(ln2>>3),ch=ln2&7; const u32x4 v=*(const u32x4*)(stg+row*64+ch*8); ATTN_STORE16(Ow+(long)row*OPITCH+ch*8,v);
      typedef _Float16 h8_t __attribute__((ext_vector_type(8))); const h8_t hv=__builtin_bit_cast(h8_t,v); float ss=0.f;
      _Pragma("unroll") for(int e=0;e<8;++e){const float f=(float)hv[e]; ss+=f*f;}
      ss+=__shfl_xor(ss,1); ss+=__shfl_xor(ss,2); ss+=__shfl_xor(ss,4); if(ch==0)SSw[(long)row*8]=ss; } }
  asm volatile("s_waitcnt lgkmcnt(0)\n\ts_barrier":::"memory");
  #undef DMA_K
  #undef DMA_V
  #undef CMASK
  #undef START
  #undef RESC
  #undef ROT
}
constexpr int ATTN_LDS_BYTES=LDS_BYTES;
struct AttnTensors { const bf16* Q; const bf16* K; const bf16* V; unsigned short* O; const unsigned* MV; float* SSA; };
struct AttnUnit { int bh; int qb; };
struct StaticOrder {
  int vcu;
  __device__ __forceinline__ explicit StaticOrder(int grid,int block):vcu((block%8)*(grid/8)+block/8){}
  __device__ __forceinline__ bool next(int i,AttnUnit&u)const{ if(i>=2)return false; const int s=vcu&15; u.bh=vcu>>4; u.qb=(i==0)?31-s:s; return true; }
  __device__ __forceinline__ void a_ready(const AttnUnit&)const{}
  __device__ __forceinline__ void done(const AttnUnit&)const{}
};
template<class Sched,int THRL=8> __device__ __forceinline__ void attn_phase(char*lds,const AttnTensors&T,const Sched&S){
  AttnUnit u;
  for(int i=0;S.next(i,u);++i){ S.a_ready(u); attn_unit<THRL>(u.bh/NHEAD,u.bh%NHEAD,u.qb,T.Q,T.K,T.V,T.O,T.MV,T.SSA,lds); S.done(u); }
}
#undef SBAR
#undef WAIT_BAR
}
#define GAS __attribute__((address_space(1)))
#define LAS __attribute__((address_space(3)))
typedef unsigned short bf16;
typedef unsigned v4u __attribute__((ext_vector_type(4)));
typedef float f32x4 __attribute__((ext_vector_type(4)));
typedef short bf16x8 __attribute__((ext_vector_type(8)));
typedef GAS unsigned gu32;
typedef GAS unsigned long long gu64;
#define RLX_AGENT __ATOMIC_RELAXED, __HIP_MEMORY_SCOPE_AGENT
#define LDS_WAIT() asm volatile("s_waitcnt lgkmcnt(0)" ::: "memory")
#define VM_WAIT() asm volatile("s_waitcnt vmcnt(0)" ::: "memory")
__device__ __forceinline__ unsigned long long rt() { return __builtin_amdgcn_s_memrealtime(); }
__device__ __forceinline__ unsigned f2bf(float f) { unsigned u = __builtin_bit_cast(unsigned, f); return (u + 0x7fffu + ((u >> 16) & 1u)) >> 16; }
__device__ __forceinline__ unsigned pk2(float lo, float hi) { return f2bf(lo) | (f2bf(hi) << 16); }

#define XB_TMO      128
#define XB_XCNT(j)  (256  + 64 * (j))
#define XB_XSUB(j)  (1280 + 64 * (j))
#define XB_XGEN(j)  (2304 + 64 * (j))
#define XB_TOP      3328
#define XB_TOPGEN   3392
#define XCD_BAR_WORDS 3456
#define XB_SPIN_CAP (1u << 18)

__device__ __forceinline__ unsigned xb_ld(unsigned* p)              { return __hip_atomic_load(p, __ATOMIC_RELAXED, __HIP_MEMORY_SCOPE_AGENT); }
__device__ __forceinline__ unsigned xb_add(unsigned* p, unsigned v) { return __hip_atomic_fetch_add(p, v, __ATOMIC_RELAXED, __HIP_MEMORY_SCOPE_AGENT); }
__device__ __forceinline__ unsigned xb_xcc_id() { return (unsigned)__builtin_amdgcn_s_getreg((3 << 11) | 20) & 0xFu; }
#define XB_SPIN(cond, bar) do { unsigned _sp = 0; while (cond) { __builtin_amdgcn_s_sleep(1); \
    if ((++_sp & 255u) == 0u) { if (xb_ld(&(bar)[XB_TMO])) break; if (_sp > XB_SPIN_CAP) { atomicAdd(&(bar)[XB_TMO], 1u); break; } } } } while (0)

struct XcdBarrier {
    unsigned* bar; unsigned x;
    volatile LAS unsigned* st;
};

__device__ __forceinline__ XcdBarrier xcd_barrier_post(unsigned* bar, volatile LAS unsigned* st) {
    XcdBarrier b; b.bar = bar; b.x = xb_xcc_id(); b.st = st;
    if (threadIdx.x == 0) (void)xb_add(&bar[XB_XCNT(b.x)], 1u);
    return b;
}
__device__ __forceinline__ void xcd_barrier_complete(unsigned* bar, unsigned x, unsigned& nloc, unsigned& nx) {
    const unsigned G = gridDim.x * gridDim.y * gridDim.z;
    unsigned sum, cnt, mine, sp = 0u;
    for (;;) {
        sum = 0u; cnt = 0u; mine = 0u;
#pragma unroll
        for (unsigned j = 0; j < 16; ++j) { const unsigned c = xb_ld(&bar[XB_XCNT(j)]); sum += c; cnt += (c > 0u) ? 1u : 0u; mine = (j == x) ? c : mine; }
        if (sum == G) break;
        __builtin_amdgcn_s_sleep(1);
        if ((++sp & 255u) == 0u) { if (xb_ld(&bar[XB_TMO])) break; if (sp > XB_SPIN_CAP) { atomicAdd(&bar[XB_TMO], 1u); break; } }
    }
    nloc = mine > 0u ? mine : 1u; nx = cnt > 0u ? cnt : 1u;
}

__device__ __forceinline__ void xcd_barrier(const XcdBarrier& b) {
    asm volatile("s_waitcnt vmcnt(0)" ::: "memory");
    __syncthreads();
    if (threadIdx.x == 0) {
        unsigned* bar = b.bar;
        __builtin_amdgcn_s_waitcnt(0);
        unsigned nloc = b.st[0], nx = b.st[1];
        if (nloc == 0u) { xcd_barrier_complete(bar, b.x, nloc, nx); b.st[0] = nloc; b.st[1] = nx; }
        const unsigned old = xb_add(&bar[XB_XSUB(b.x)], 1u);
        const unsigned gen = old / nloc;
        if (old + 1u == (gen + 1u) * nloc) {
            __builtin_amdgcn_fence(__ATOMIC_RELEASE, "agent");
            asm volatile("s_waitcnt vmcnt(0)" ::: "memory");
            const unsigned og = xb_add(&bar[XB_TOP], 1u);
            const unsigned tg = og / nx;
            if (og + 1u == (tg + 1u) * nx) xb_add(&bar[XB_TOPGEN], 1u);
            else XB_SPIN(xb_ld(&bar[XB_TOPGEN]) == tg, bar);
            __builtin_amdgcn_fence(__ATOMIC_ACQUIRE, "agent");
            xb_add(&bar[XB_XGEN(b.x)], 1u);
            asm volatile("s_waitcnt vmcnt(0)" ::: "memory");
        } else {
            XB_SPIN(xb_ld(&bar[XB_XGEN(b.x)]) == gen, bar);
            __builtin_amdgcn_fence(__ATOMIC_ACQUIRE, "agent");
            asm volatile("s_waitcnt vmcnt(0)" ::: "memory");
        }
    }
    __syncthreads();
}
typedef _Float16 f16x2_t __attribute__((ext_vector_type(2)));
typedef _Float16 h8 __attribute__((ext_vector_type(8)));
typedef float f32x16 __attribute__((ext_vector_type(16)));
struct Args { const float* in[16]; float* out; unsigned char* ws; float inv_freq[32]; int ph_lo, ph_hi, li, pad; };
struct Frame {
    LAS unsigned char* lds; volatile LAS unsigned* MISC; gu32* ctl;
    int tid, lane, wave, vcu, G;
    unsigned char* ws;
};
__device__ __forceinline__ float wave_sum(float v) {
#pragma unroll
    for (int o = 1; o < 64; o <<= 1) v += __shfl_xor(v, o);
    return v;
}
__device__ __forceinline__ float ld_agent(const float* p) { return __hip_atomic_load(p, __ATOMIC_RELAXED, __HIP_MEMORY_SCOPE_AGENT); }
__device__ __forceinline__ unsigned pkh(float lo, float hi) { return pg8::pk_f16(lo, hi); }

__device__ __forceinline__ void tr_item(const float* W, int ldw, int K, int k0, int src_col0, unsigned short* WT, int dst_row0, const float* ks0, const float* ks1, LAS float* scr, int lane) {
#pragma unroll 8
    for (int i = 0; i < 32; ++i) { const int kk = 2 * i + (lane >> 5); float v = W[(size_t)(k0 + kk) * ldw + src_col0 + (lane & 31)];
        if (ks0) { float s = ks0[k0 + kk]; if (ks1) s *= 1.0f + ld_agent(ks1 + k0 + kk); v *= s; }
        scr[kk * 33 + (lane & 31)] = v; }
    LDS_WAIT(); asm volatile("" ::: "memory");
    const int c = lane & 7;
#pragma unroll
    for (int j = 0; j < 4; ++j) { const int n = (lane >> 3) + 8 * j; const LAS float* s = scr + (8 * c) * 33 + n;
        v4u o; o.x = pkh(s[0 * 33], s[1 * 33]); o.y = pkh(s[2 * 33], s[3 * 33]); o.z = pkh(s[4 * 33], s[5 * 33]); o.w = pkh(s[6 * 33], s[7 * 33]);
        *(GAS v4u*)(WT + (size_t)(dst_row0 + n) * K + k0 + 8 * c) = o; }
    LDS_WAIT(); asm volatile("" ::: "memory");
}
__device__ __forceinline__ void sincos_d(double x, float& s, float& c) {
    const double n = __builtin_rint(x * 0.63661977236758134308);
    double r = __builtin_fma(-n, 1.57079632679489655800e+00, x); r = __builtin_fma(-n, 6.12323399573676603587e-17, r);
    const int q = (int)n & 3; const double r2 = r * r;
    const double sp = r * (1.0 + r2 * (-1.0 / 6.0 + r2 * (1.0 / 120.0 + r2 * (-1.0 / 5040.0 + r2 * (1.0 / 362880.0 + r2 * (-1.0 / 39916800.0 + r2 * (1.0 / 6227020800.0 + r2 * (-1.0 / 1307674368000.0))))))));
    const double cp = 1.0 + r2 * (-0.5 + r2 * (1.0 / 24.0 + r2 * (-1.0 / 720.0 + r2 * (1.0 / 40320.0 + r2 * (-1.0 / 3628800.0 + r2 * (1.0 / 479001600.0 + r2 * (-1.0 / 87178291200.0 + r2 * (1.0 / 20922789888000.0))))))));
    const double sv = (q == 0) ? sp : (q == 1) ? cp : (q == 2) ? -sp : -cp, cv = (q == 0) ? cp : (q == 1) ? -sp : (q == 2) ? -cp : sp;
    s = (float)sv; c = (float)cv;
}

__device__ __forceinline__ void p0_prologue(Frame& F, const Args& a) {
    LAS float* scr = (LAS float*)(F.lds + RING_OFF + F.wave * 16384);
    const int gw = F.vcu * NWAVES + F.wave, NGW = F.G * NWAVES;
    const float* w_in = a.in[5]; const float* w_out = a.in[11]; const float* w_ff2 = a.in[14];
    unsigned short* Win = (unsigned short*)(F.ws + WS_WIN); unsigned short* Wsm = (unsigned short*)(F.ws + WS_WSM);
    unsigned short* Wout = (unsigned short*)(F.ws + WS_WOUT); unsigned short* Wff2 = (unsigned short*)(F.ws + WS_WFF2);
    constexpr int I_IN = 16 * 96, I_SM = 16 * 3, I_OUT = 16 * 32, I_FF2 = 64 * 32, I_MOD = 96 * 8;
    constexpr int NITEMS = I_IN + I_SM + I_OUT + I_FF2 + I_MOD;
    for (int it = gw; it < NITEMS; it += NGW) {
        int r = it;
        if (r < I_MOD) {
            const int jb = r >> 3, ks = r & 7, j = 64 * jb + F.lane; const float* c = a.in[1]; const float* aw = a.in[2]; const float* ab = a.in[3];
            float a0 = 0.f, a1 = 0.f;
#pragma unroll 1
            for (int half = 0; half < 2; ++half) { const int kb = 128 * ks + 64 * half;
                const float c0 = c[kb + F.lane], c1 = c[D + kb + F.lane];
                const float s0 = c0 / (1.0f + expf(-c0)), s1 = c1 / (1.0f + expf(-c1));
#pragma unroll 16
                for (int kk = 0; kk < 64; ++kk) { const float w = aw[(size_t)(kb + kk) * 6144 + j];
                    a0 += __shfl(s0, kk) * w; a1 += __shfl(s1, kk) * w; } }
            if (ks == 0) { a0 += ab[j]; a1 += ab[j]; }
            float* mod = (float*)(F.ws + CTL_MOD);
            atomicAdd(mod + j, a0); atomicAdd(mod + 6144 + j, a1);
            continue; }
        r -= I_MOD;
        if (r < I_IN) { const int kb = r / 96, nb = r % 96, pn = nb >> 3, rem = nb & 7, bj = rem >> 2, wc = rem & 3, sec = pn >> 1, head = 4 * (pn & 1) + wc;
            const int base = sec == 0 ? SEC_Q : sec == 1 ? SEC_K : sec == 2 ? SEC_V : sec == 3 ? SEC_QI : sec == 4 ? SEC_GU : SEC_GV;
            tr_item(w_in, IN_COLS, D, 64 * kb, base + head * 64 + 32 * bj, Win, 32 * nb, nullptr, nullptr, scr, F.lane); continue; }
        r -= I_IN;
        if (r < I_SM) { const int kb = r / 3, nb = r % 3; tr_item(w_in, IN_COLS, D, 64 * kb, SEC_KI + 32 * nb, Wsm, 32 * nb, nullptr, nullptr, scr, F.lane); continue; }
        r -= I_SM;
        if (r < I_OUT) { const int kb = r / 32, nb = r % 32; const float* beta = (kb < 8) ? a.in[9] : (a.in[10] - 512);
            tr_item(w_out, D, D, 64 * kb, 32 * nb, Wout, 32 * nb, beta, nullptr, scr, F.lane); continue; }
        r -= I_OUT;
        { const int kb = r / 32, nb = r % 32; tr_item(w_ff2, D, FF, 64 * kb, 32 * nb, Wff2, 32 * nb, nullptr, nullptr, scr, F.lane); }
    }
    { float* cosT = (float*)(F.ws + WS_COS); float* sinT = (float*)(F.ws + WS_SIN);
      for (int e = gw * 64 + F.lane; e < T * 32; e += NGW * 64) { const int pos = e >> 5, i = e & 31;
          const float ang = __fmul_rn((float)pos, a.inv_freq[i]); float s, c; sincos_d((double)ang, s, c); cosT[e] = c; sinT[e] = s; } }
    { const float* wsp = a.in[6]; unsigned short* o = (unsigned short*)(F.ws + WS_WSP);
      for (int e = gw * 64 + F.lane; e < 8 * 128 * 128 / 2; e += NGW * 64) { const int t = (2 * e >> 7) & 127, s = (2 * e) & 127;
          const float v0 = s <= t ? wsp[2 * e] : 0.f, v1 = (s + 1) <= t ? wsp[2 * e + 1] : 0.f; ((unsigned*)o)[e] = pkh(v0, v1); } }
}

__device__ __forceinline__ void p1_prologue(Frame& F, const Args& a) {
    LAS float* scr = (LAS float*)(F.lds + RING_OFF + F.wave * 16384);
    const int gw = F.vcu * NWAVES + F.wave, NGW = F.G * NWAVES;
    const float* mod = (const float*)(F.ws + CTL_MOD);
    const float* w_ff1 = a.in[13]; unsigned short* Wff1 = (unsigned short*)(F.ws + WS_WFF1);
    constexpr int I_FF1 = 2 * 16 * 128, I_B1 = 64 * 8;
    for (int it = gw; it < I_FF1 + I_B1; it += NGW) {
        int r = it;
        if (r < I_B1) {
            const int nb = r >> 3, ks = r & 7, n = 64 * nb + F.lane; float a0 = 0.f, a1 = 0.f;
#pragma unroll 1
            for (int half = 0; half < 2; ++half) { const int kb = 128 * ks + 64 * half;
                const float s0 = ld_agent(mod + 3072 + kb + F.lane), s1 = ld_agent(mod + 6144 + 3072 + kb + F.lane);
#pragma unroll 16
                for (int kk = 0; kk < 64; ++kk) { const float w = w_ff1[(size_t)(kb + kk) * FF + n]; a0 += __shfl(s0, kk) * w; a1 += __shfl(s1, kk) * w; } }
            float* b1 = (float*)(F.ws + CTL_BIAS1); atomicAdd(b1 + n, a0); atomicAdd(b1 + FF + n, a1);
            continue; }
        r -= I_B1;
        { const int b = r / (16 * 128), rr = r % (16 * 128), kb = rr / 128, nb = rr % 128;
          tr_item(w_ff1, FF, D, 64 * kb, 32 * nb, Wff1 + (size_t)b * FF * D, 32 * nb, a.in[12], mod + b * 6144 + 4096, scr, F.lane); }
    }
    __syncthreads();
    const float* x = a.in[0]; const float* n1g = a.in[4];
    unsigned short* H1 = (unsigned short*)(F.ws + WS_H1); unsigned short* KI = (unsigned short*)(F.ws + WS_KI); float* WI = (float*)(F.ws + WS_WI);
    const unsigned short* Wsm = (const unsigned short*)(F.ws + WS_WSM);
    const float* cosT = (const float*)(F.ws + WS_COS); const float* sinT = (const float*)(F.ws + WS_SIN);
    constexpr int HSTR = 2064;
    for (int blk = F.vcu; blk < M / 64; blk += F.G) {
        const int row0 = 64 * blk, b = row0 >> 13;
        f32x4 gs[4], sh[4];
#pragma unroll
        for (int j = 0; j < 4; ++j) { const int c = 4 * F.lane + 256 * j;
#pragma unroll
            for (int e = 0; e < 4; ++e) { gs[j][e] = n1g[c + e] * (1.0f + ld_agent(mod + b * 6144 + 1024 + c + e)); sh[j][e] = ld_agent(mod + b * 6144 + c + e); } }
#pragma unroll 1
        for (int rr = 0; rr < 8; ++rr) { const int rl = 8 * F.wave + rr, row = row0 + rl;
            const GAS f32x4* xr = (const GAS f32x4*)(x + (size_t)row * D) + F.lane; f32x4 v[4]; float s2 = 0.f;
#pragma unroll
            for (int j = 0; j < 4; ++j) { v[j] = xr[64 * j]; s2 += (v[j].x * v[j].x + v[j].y * v[j].y) + (v[j].z * v[j].z + v[j].w * v[j].w); }
            const float rstd = 1.0f / sqrtf(wave_sum(s2) * (1.0f / D) + 1e-6f);
#pragma unroll
            for (int j = 0; j < 4; ++j) { const f32x4 hq = v[j] * rstd * gs[j] + sh[j];
                const unsigned long long pk = (unsigned long long)pkh(hq.x, hq.y) | ((unsigned long long)pkh(hq.z, hq.w) << 32);
                *((GAS unsigned long long*)(H1 + (size_t)row * D) + F.lane + 64 * j) = pk;
                *(LAS unsigned long long*)(F.lds + rl * HSTR + (4 * F.lane + 256 * j) * 2) = pk; } }
        __syncthreads();
        { const int fr = F.lane & 15, fq = F.lane >> 4;
          if (F.wave < 4) {
              const int rt = F.wave; f32x4 acc[4];
#pragma unroll
              for (int ct = 0; ct < 4; ++ct) acc[ct] = (f32x4){0.f, 0.f, 0.f, 0.f};
#pragma unroll 2
              for (int ks = 0; ks < 32; ++ks) { const h8 hb = *(const LAS h8*)(F.lds + (16 * rt + fr) * HSTR + (32 * ks + 8 * fq) * 2);
#pragma unroll
                  for (int ct = 0; ct < 4; ++ct) { const h8 wa = *(const GAS h8*)(Wsm + (size_t)(16 * ct + fr) * D + 32 * ks + 8 * fq);
                      acc[ct] = __builtin_amdgcn_mfma_f32_16x16x32_f16(wa, hb, acc[ct], 0, 0, 0); } }
              const int row = row0 + 16 * rt + fr, pos = row & 8191; float n2 = 0.f;
#pragma unroll
              for (int ct = 0; ct < 2; ++ct) { const int d = 16 * ct + 4 * fq;
                  const f32x4 c = *(const f32x4*)(cosT + pos * 32 + d), s = *(const f32x4*)(sinT + pos * 32 + d);
                  const f32x4 lo = acc[ct] * c - acc[ct + 2] * s, hi = acc[ct] * s + acc[ct + 2] * c;
                  const unsigned l0 = pkh(lo[0], lo[1]), l1 = pkh(lo[2], lo[3]), h0 = pkh(hi[0], hi[1]), h1 = pkh(hi[2], hi[3]);
                  *(GAS unsigned long long*)(KI + (size_t)row * 64 + d) = (unsigned long long)l0 | ((unsigned long long)l1 << 32);
                  *(GAS unsigned long long*)(KI + (size_t)row * 64 + 32 + d) = (unsigned long long)h0 | ((unsigned long long)h1 << 32);
                  const f16x2_t a0 = __builtin_bit_cast(f16x2_t, l0), a1 = __builtin_bit_cast(f16x2_t, l1), b0 = __builtin_bit_cast(f16x2_t, h0), b1 = __builtin_bit_cast(f16x2_t, h1);
                  n2 += (float)a0[0] * (float)a0[0] + (float)a0[1] * (float)a0[1] + (float)a1[0] * (float)a1[0] + (float)a1[1] * (float)a1[1]
                      + (float)b0[0] * (float)b0[0] + (float)b0[1] * (float)b0[1] + (float)b1[0] * (float)b1[0] + (float)b1[1] * (float)b1[1]; }
              n2 += __shfl_xor(n2, 16); n2 += __shfl_xor(n2, 32);
#pragma unroll
              for (int o = 1; o < 16; o <<= 1) n2 = fmaxf(n2, __shfl_xor(n2, o));
              if (F.lane == 0) atomicMax((unsigned*)(F.ctl + CW_KMAX + b), __float_as_uint(n2));
          } else {
              const int rt = F.wave - 4; f32x4 acc = (f32x4){0.f, 0.f, 0.f, 0.f};
#pragma unroll 4
              for (int ks = 0; ks < 32; ++ks) { const h8 hb = *(const LAS h8*)(F.lds + (16 * rt + fr) * HSTR + (32 * ks + 8 * fq) * 2);
                  const h8 wa = *(const GAS h8*)(Wsm + (size_t)(64 + fr) * D + 32 * ks + 8 * fq);
                  acc = __builtin_amdgcn_mfma_f32_16x16x32_f16(wa, hb, acc, 0, 0, 0); }
              if (fq < 2) *(GAS f32x4*)(WI + (size_t)(row0 + 16 * rt + fr) * 8 + 4 * fq) = acc;
          } }
        __syncthreads();
    }
}

__device__ __forceinline__ void p8_final(Frame& F, const Args& a) {
    const int gw = F.vcu * NWAVES + F.wave, NGW = F.G * NWAVES;
    const float* fg = a.in[15]; const float* ss = (const float*)(F.ws + WS_SSX2);
    f32x4 g[4];
#pragma unroll
    for (int j = 0; j < 4; ++j) g[j] = *(const f32x4*)(fg + 4 * F.lane + 256 * j);
    for (int m = gw; m < M; m += NGW) {
        const float rstd = pg8::rstd_from16(ss + (size_t)m * 16, 1.0f / 1024.0f);
        GAS f32x4* xr = (GAS f32x4*)(a.out + (size_t)m * D) + F.lane;
#pragma unroll
        for (int j = 0; j < 4; ++j) xr[64 * j] = xr[64 * j] * rstd * g[j];
    }
}
__device__ __forceinline__ int crow16(int r, int hi) { return (r & 3) + 8 * (r >> 2) + 4 * hi; }
__device__ __forceinline__ void gmlp_unit(Frame& F, const Args& a, int b, int c) {
    const int g = F.wave, q = F.lane & 31, hi = F.lane >> 5;
    const size_t row0 = (size_t)b * T + 128 * c;
    const unsigned short* WSP = (const unsigned short*)(F.ws + WS_WSP); const unsigned short* VN = (const unsigned short*)(F.ws + WS_VN);
    const unsigned short* GU = (const unsigned short*)(F.ws + WS_GU); unsigned short* MRG = (unsigned short*)(F.ws + WS_MRG); float* SSG = (float*)(F.ws + WS_SSG);
    const float* bsp = a.in[7];
    f32x16 acc[4][2];
#pragma unroll
    for (int rt = 0; rt < 4; ++rt)
#pragma unroll
        for (int dt = 0; dt < 2; ++dt) acc[rt][dt] = f32x16{};
#pragma unroll
    for (int kk = 0; kk < 8; ++kk) {
        h8 bf[2];
#pragma unroll
        for (int dt = 0; dt < 2; ++dt) { typedef unsigned short us8 __attribute__((ext_vector_type(8))); us8 t;
#pragma unroll
            for (int j = 0; j < 8; ++j) t[j] = VN[(row0 + 16 * kk + 8 * hi + j) * 512 + g * 64 + 32 * dt + q];
            bf[dt] = __builtin_bit_cast(h8, t); }
#pragma unroll
        for (int rt = 0; rt < 4; ++rt) if (16 * kk <= 32 * rt + 31) {
            const h8 af = *(const GAS h8*)(WSP + (size_t)(g * 128 + 32 * rt + q) * 128 + 16 * kk + 8 * hi);
#pragma unroll
            for (int dt = 0; dt < 2; ++dt) acc[rt][dt] = __builtin_amdgcn_mfma_f32_32x32x16_f16(af, bf[dt], acc[rt][dt], 0, 0, 0); }
    }
#pragma unroll
    for (int rt = 0; rt < 4; ++rt)
#pragma unroll
        for (int r = 0; r < 16; ++r) { const int t = 32 * rt + crow16(r, hi); const size_t row = row0 + t; const float bias = bsp[g * 128 + t]; float ss = 0.f;
#pragma unroll
            for (int dt = 0; dt < 2; ++dt) { const int d = g * 64 + 32 * dt + q; const float mixed = acc[rt][dt][r] + bias;
                const _Float16 gu = __builtin_bit_cast(_Float16, GU[row * 512 + d]); const _Float16 o = (_Float16)((float)gu * mixed);
                MRG[row * 1024 + 512 + d] = __builtin_bit_cast(unsigned short, o); ss += (float)o * (float)o; }
#pragma unroll
            for (int o = 1; o < 32; o <<= 1) ss += __shfl_xor(ss, o);
            if (q == 0) SSG[row * 8 + g] = ss; }
}

constexpr int IX_HIST = 0, IX_IMG = 0, IX_CX = 32768, IX_CI = 65536, IX_SM = 131072;
__device__ __forceinline__ unsigned cm16(int q, int hi) { unsigned m = 0u;
#pragma unroll
    for (int r = 0; r < 16; ++r) m |= (crow16(r, hi) <= q) ? (1u << r) : 0u;
    return m; }
__device__ __forceinline__ void compute_x(const h8 (&kf)[4], const h8 (&qf)[8][4], const float (&wp)[8], f32x16& x) {
#pragma unroll
    for (int r = 0; r < 16; ++r) x[r] = 1.5f;
#pragma unroll
    for (int h = 0; h < 8; ++h) { f32x16 acc = f32x16{};
#pragma unroll
        for (int kk = 0; kk < 4; ++kk) acc = __builtin_amdgcn_mfma_f32_32x32x16_f16(kf[kk], qf[h][kk], acc, 0, 0, 0);
#pragma unroll
        for (int r = 0; r < 16; ++r) { const int ai = __float_as_int(acc[r]); const float m = __int_as_float(ai > 0 ? ai : 0);
            asm volatile("v_fmac_f32_e32 %0, %1, %2" : "+v"(x[r]) : "v"(wp[h]), "v"(m)); } }
}
__device__ __forceinline__ void index_unit(Frame& F, int b, int qb) {
    const int lane = F.lane, q = lane & 31, hi = lane >> 5, wid = F.wave;
    const size_t rowq = (size_t)b * T + 32 * qb + q;
    LAS unsigned* HIST = (LAS unsigned*)(F.lds + IX_HIST); LAS unsigned* IMG = (LAS unsigned*)(F.lds + IX_IMG);
    LAS float* CX = (LAS float*)(F.lds + IX_CX); LAS unsigned short* CI = (LAS unsigned short*)(F.lds + IX_CI);
    LAS unsigned* PART = (LAS unsigned*)(F.lds + IX_SM); LAS float* LO = (LAS float*)(F.lds + IX_SM + 1024); LAS float* HI = (LAS float*)(F.lds + IX_SM + 1152);
    LAS unsigned* NEED = (LAS unsigned*)(F.lds + IX_SM + 1280); LAS unsigned* CCNT = (LAS unsigned*)(F.lds + IX_SM + 1408);
    unsigned* MV = (unsigned*)(F.ws + WS_MASK) + ((size_t)(b * 256 + qb) * 128) * 64;
    const int ntw = 4 * ((qb >> 3) + 1);
    if (qb < 8) {
        for (int e = F.tid; e < ntw * 64; e += NWAVES * 64) { const int t64 = e >> 6, ln = e & 63; unsigned w = 0u;
#pragma unroll
            for (int p = 0; p < 2; ++p) { const int j = 2 * t64 + p; if (j < qb) w |= 0xFFFFu << (16 * p); else if (j == qb) w |= cm16(ln & 31, ln >> 5) << (16 * p); }
            MV[e] = w; }
        return; }
    const unsigned short* QI = (const unsigned short*)(F.ws + WS_QI); const unsigned short* KI = (const unsigned short*)(F.ws + WS_KI); const float* WI = (const float*)(F.ws + WS_WI);
    h8 qf[8][4]; float wp[8]; float Bt = 0.f;
#pragma unroll
    for (int h = 0; h < 8; ++h) { float n2 = 0.f;
#pragma unroll
        for (int kk = 0; kk < 4; ++kk) { qf[h][kk] = *(const GAS h8*)(QI + rowq * 512 + h * 64 + 16 * kk + 8 * hi);
#pragma unroll
            for (int j = 0; j < 8; ++j) { const float f = (float)qf[h][kk][j]; n2 += f * f; } }
        n2 += __shfl_xor(n2, 32);
        const float w = WI[rowq * 8 + h] * 0.35355339059327373f; wp[h] = w; Bt += fabsf(w) * sqrtf(n2); }
    { const float kmax = sqrtf(__uint_as_float(__hip_atomic_load((unsigned*)(F.ctl + CW_KMAX + b), __ATOMIC_RELAXED, __HIP_MEMORY_SCOPE_AGENT)));
      Bt *= kmax * 0.125f * 1.03f; const float sc = Bt > 1e-30f ? 0.4995f / Bt : 0.f;
#pragma unroll
      for (int h = 0; h < 8; ++h) wp[h] *= 0.125f * sc; }
    for (int e = F.tid; e < 8192; e += NWAVES * 64) ((LAS v4u*)HIST)[e] = (v4u){0u, 0u, 0u, 0u};
    __syncthreads();
    for (int j = wid; j <= qb; j += 8) {
        h8 kf[4]; const size_t rowk = (size_t)b * T + 32 * j + q;
#pragma unroll
        for (int kk = 0; kk < 4; ++kk) kf[kk] = *(const GAS h8*)(KI + rowk * 64 + 16 * kk + 8 * hi);
        f32x16 x; compute_x(kf, qf, wp, x);
        const unsigned cm = (j < qb) ? 0xFFFFu : cm16(q, hi);
#pragma unroll
        for (int r = 0; r < 16; ++r) { const unsigned xb = ((cm >> r) & 1u) ? __float_as_uint(x[r]) : 0x3F800000u;
            const unsigned bin = (xb >> 13) & 1023u;
            __hip_atomic_fetch_add(HIST + bin * 32 + q, 1u, __ATOMIC_RELAXED, __HIP_MEMORY_SCOPE_WORKGROUP); }
    }
    __syncthreads();
    if (lane < 32) { unsigned s = 0u;
#pragma unroll 8
        for (int i = 0; i < 128; ++i) s += HIST[(128 * wid + i) * 32 + lane];
        PART[wid * 32 + lane] = s; }
    __syncthreads();
    if (wid == 0 && lane < 32) {
        unsigned A = 0u; int seg = 7;
        for (; seg > 0; --seg) { const unsigned p = PART[seg * 32 + lane]; if (A + p >= (unsigned)TOPK) break; A += p; }
        int bsel = 128 * seg;
        for (int i = 127; i >= 0; --i) { const unsigned c = HIST[(128 * seg + i) * 32 + lane]; if (A + c >= (unsigned)TOPK) { bsel = 128 * seg + i; break; } A += c; }
        LO[lane] = __uint_as_float(0x3F800000u + ((unsigned)bsel << 13)); HI[lane] = __uint_as_float(0x3F800000u + ((unsigned)(bsel + 1) << 13));
        NEED[lane] = (A < (unsigned)TOPK) ? (unsigned)TOPK - A : 0u; }
    __syncthreads();
    for (int e = F.tid; e < ntw * 64; e += NWAVES * 64) IMG[e] = 0u;
    if (F.tid < 32) CCNT[F.tid] = 0u;
    __syncthreads();
    { const float lo_e = LO[q], hi_e = HI[q];
      for (int j = wid; j <= qb; j += 8) {
        h8 kf[4]; const size_t rowk = (size_t)b * T + 32 * j + q;
#pragma unroll
        for (int kk = 0; kk < 4; ++kk) kf[kk] = *(const GAS h8*)(KI + rowk * 64 + 16 * kk + 8 * hi);
        f32x16 x; compute_x(kf, qf, wp, x);
        const unsigned cm = (j < qb) ? 0xFFFFu : cm16(q, hi);
        unsigned w = 0u;
#pragma unroll
        for (int r = 15; r >= 0; --r) w = __builtin_amdgcn_alignbit(w, __float_as_uint(x[r] - hi_e), 31u);
        const unsigned sel = ~w & cm & 0xFFFFu;
        unsigned wl = 0u;
#pragma unroll
        for (int r = 15; r >= 0; --r) wl = __builtin_amdgcn_alignbit(wl, __float_as_uint(x[r] - lo_e), 31u);
        const unsigned cand = ~wl & w & cm & 0xFFFFu;
        if (__builtin_amdgcn_ballot_w64(cand != 0u) != 0ull)
#pragma unroll
        for (int r = 0; r < 16; ++r) {
            if ((cand >> r) & 1u) { const unsigned slot = __hip_atomic_fetch_add(CCNT + q, 1u, __ATOMIC_RELAXED, __HIP_MEMORY_SCOPE_WORKGROUP);
                if (slot < 256u) { CX[q * 256 + slot] = x[r]; CI[q * 256 + slot] = (unsigned short)(32 * j + crow16(r, hi)); } } }
        ((LAS unsigned short*)IMG)[((j >> 1) * 64 + lane) * 2 + (j & 1)] = (unsigned short)sel;
      } }
    __syncthreads();
#pragma unroll 1
    for (int qi_ = 0; qi_ < 4; ++qi_) { const int qq = 4 * wid + qi_; const unsigned cn = CCNT[qq]; const int C = (int)(cn < 256u ? cn : 256u); const unsigned nd = NEED[qq];
#pragma unroll 1
        for (int c0 = 0; c0 < C; c0 += 64) { const int i = c0 + lane; const bool valid = i < C; const float xi = valid ? CX[qq * 256 + i] : 0.f; const unsigned ki = valid ? CI[qq * 256 + i] : 0u;
            unsigned rank = 0u;
            for (int jx = 0; jx < C; ++jx) { const float xj = CX[qq * 256 + jx]; const unsigned kj = CI[qq * 256 + jx]; rank += (xj > xi || (xj == xi && kj < ki)) ? 1u : 0u; }
            if (valid && rank < nd) { const unsigned kk = ki & 31u, part = (ki >> 5) & 1u, t64 = ki >> 6, hh = (kk >> 2) & 1u, r = (kk & 3u) + 4u * (kk >> 3);
                __hip_atomic_fetch_or(IMG + t64 * 64 + hh * 32 + qq, 1u << (16u * part + r), __ATOMIC_RELAXED, __HIP_MEMORY_SCOPE_WORKGROUP); } } }
    __syncthreads();
    for (int e = F.tid; e < ntw * 64; e += NWAVES * 64) MV[e] = IMG[e];
    __syncthreads();
}
__device__ __forceinline__ void p3_mixers(Frame& F, const Args& a) {
#ifndef NO_GMLP
    for (int u = F.vcu; u < 128; u += F.G) gmlp_unit(F, a, u >> 6, u & 63);
#endif
    __syncthreads();
#ifndef NO_INDEX
    for (int p = F.vcu; p < 256; p += F.G) { const int b = p >> 7, i = p & 127; index_unit(F, b, 255 - i); index_unit(F, b, i); }
#endif
}

constexpr int PER_PHASE = 9;
constexpr int N_LAUNCHES = MK_N_LAUNCHES;
__global__ void __launch_bounds__(NWAVES * 64, 2) hymba_fwd(Args args) {
    extern __shared__ __attribute__((aligned(16))) unsigned char lds[];
    Frame F;
    F.lds = (LAS unsigned char*)lds; F.MISC = (volatile LAS unsigned*)(F.lds + MISC_OFF);
    F.tid = threadIdx.x; F.lane = F.tid & 63; F.wave = __builtin_amdgcn_readfirstlane(F.tid >> 6);
    F.G = gridDim.x; { const int bx = blockIdx.x; F.vcu = (F.G % 8 == 0) ? (bx % 8) * (F.G / 8) + bx / 8 : bx; }
    F.ws = args.ws; F.ctl = (gu32*)(args.ws + WS_CTL);
    for (int u = F.tid; u < (LDS_BYTES - LDSCTL_OFF) / 4; u += NWAVES * 64) ((LAS unsigned*)(F.lds + LDSCTL_OFF))[u] = 0u;
    __syncthreads();
    if (N_LAUNCHES == 1) (void)xcd_barrier_post((unsigned*)(args.ws + WS_CTL) + CW_BAR, (volatile LAS unsigned*)((LAS unsigned char*)lds + MISC_OFF) + 8);
#define GRID_BAR() do { if (N_LAUNCHES == 1) { XcdBarrier bar_; bar_.bar = (unsigned*)(args.ws + WS_CTL) + CW_BAR; bar_.x = xb_xcc_id(); bar_.st = (volatile LAS unsigned*)((LAS unsigned char*)lds + MISC_OFF) + 8; xcd_barrier(bar_); } } while (0)
    const int lo = args.ph_lo, hi = args.ph_hi;
#ifndef PH_MASK
#define PH_MASK 0x1ff
#endif
#define IN(k) (((PH_MASK >> (k)) & 1) && lo <= (k) && (k) < hi)
#define BOTH(k) (IN(k) && IN((k) + 1))
    unsigned char* ws = args.ws;
    if (IN(0)) { p0_prologue(F, args); if (BOTH(0)) GRID_BAR(); }
    if (IN(1)) { p1_prologue(F, args); if (BOTH(1)) GRID_BAR(); }
    if (IN(2)) {
        pg8::Gemm g{(const pg8::bf16_t*)(ws + WS_H1), (const pg8::bf16_t*)(ws + WS_WIN), M, NIN, D, 0}; pg8::StaticOrder S; S.init(M, NIN, F.G, (int)blockIdx.x);
        pg8::EpiInProj E{(unsigned short*)(ws + WS_Q), (unsigned short*)(ws + WS_K), (unsigned short*)(ws + WS_V), (unsigned short*)(ws + WS_QI), (unsigned short*)(ws + WS_GU), (unsigned short*)(ws + WS_VN),
                         (const float*)(ws + WS_COS), (const float*)(ws + WS_SIN), args.in[8]};
        pg8::gemm_phase<pg8::EpiInProj, pg8::StaticOrder, true, true>(F.lds + RING_OFF, g, S, E);
        if (BOTH(2)) GRID_BAR();
    }
    if (IN(3)) { p3_mixers(F, args); if (BOTH(3)) GRID_BAR(); }
    if (IN(4)) {
        const attn_body::AttnTensors AT{(const attn_body::bf16*)(ws + WS_Q), (const attn_body::bf16*)(ws + WS_K), (const attn_body::bf16*)(ws + WS_V), (unsigned short*)(ws + WS_MRG),
                                        (const unsigned*)(ws + WS_MASK), (float*)(ws + WS_SSA)};
        const attn_body::StaticOrder S((int)F.G, (int)blockIdx.x);
        attn_body::attn_phase<attn_body::StaticOrder>((char*)lds + RING_OFF, AT, S);
        if (BOTH(4)) GRID_BAR();
    }
    if (IN(5)) {
        pg8::Gemm g{(const pg8::bf16_t*)(ws + WS_MRG), (const pg8::bf16_t*)(ws + WS_WOUT), M, D, D, 0}; pg8::StaticOrder S; S.init(M, D, F.G, (int)blockIdx.x);
        LAS float* rowf = (LAS float*)(F.lds + 131072);
        pg8::EpiOutProj E{args.in[0], args.out, (unsigned short*)(ws + WS_X1H), (const float*)(ws + CTL_MOD) + 2048, rowf, (float*)(ws + WS_SSX1)};
        for (int i = 0;; ++i) { pg8::Unit u; if (!S.next(i, u)) break;
            if (F.tid < 256) { const size_t row = (size_t)u.pm * 256 + F.tid;
                const float ra = pg8::rstd_from8((const float*)(ws + WS_SSA) + row * 8, 1.0f / 512.0f), rg = pg8::rstd_from8((const float*)(ws + WS_SSG) + row * 8, 1.0f / 512.0f);
                rowf[2 * F.tid] = ra / rg; rowf[2 * F.tid + 1] = rg; }
            __syncthreads();
            pg8::SingleOrder S1{u};
            pg8::gemm_phase<pg8::EpiOutProj, pg8::SingleOrder, false, true>(F.lds + RING_OFF, g, S1, E);
            __syncthreads(); }
        if (BOTH(5)) GRID_BAR();
    }
    if (IN(6)) {
        pg8::Gemm g{(const pg8::bf16_t*)(ws + WS_X1H), (const pg8::bf16_t*)(ws + WS_WFF1), M, FF, D, (size_t)FF * D * 2}; pg8::StaticOrder S; S.init(M, FF, F.G, (int)blockIdx.x);
        pg8::EpiFF1 E{(unsigned short*)(ws + WS_U), (const float*)(ws + CTL_BIAS1), (const float*)(ws + WS_SSX1)};
        pg8::gemm_phase<pg8::EpiFF1, pg8::StaticOrder, true, true>(F.lds + RING_OFF, g, S, E);
        if (BOTH(6)) GRID_BAR();
    }
    if (IN(7)) {
        pg8::Gemm g{(const pg8::bf16_t*)(ws + WS_U), (const pg8::bf16_t*)(ws + WS_WFF2), M, D, FF, 0}; pg8::StaticOrder S; S.init(M, D, F.G, (int)blockIdx.x);
        pg8::EpiFF2 E{args.out, (const float*)(ws + CTL_MOD) + 5120, (float*)(ws + WS_SSX2)};
        pg8::gemm_phase<pg8::EpiFF2, pg8::StaticOrder, false, true>(F.lds + RING_OFF, g, S, E);
        if (BOTH(7)) GRID_BAR();
    }
    if (IN(8)) p8_final(F, args);
#undef IN
#undef BOTH
}

extern "C" void kernel_launch(void* const* d_in, const int* in_sizes, int n_in, void* d_out, int out_size, void* d_ws, size_t ws_size, hipStream_t stream) {
    static int grid = 0;
    if (grid == 0) {
        if (n_in != 16 || in_sizes[0] != M * D || out_size != M * D || ws_size < WS_END) { fprintf(stderr, "kernel_launch: unexpected shapes (n_in %d, in0 %d, out %d, ws %zu); nothing launched\n", n_in, n_in > 0 ? in_sizes[0] : -1, out_size, ws_size); grid = -1; return; }
        int dev = 0, cus = 0, per_cu = 0;
        if (hipGetDevice(&dev) != hipSuccess || hipDeviceGetAttribute(&cus, hipDeviceAttributeMultiprocessorCount, dev) != hipSuccess) { grid = -1; return; }
        if (hipFuncSetAttribute((const void*)hymba_fwd, hipFuncAttributeMaxDynamicSharedMemorySize, LDS_BYTES) != hipSuccess) { fprintf(stderr, "kernel_launch: hipFuncSetAttribute failed\n"); grid = -1; return; }
        if (hipOccupancyMaxActiveBlocksPerMultiprocessor(&per_cu, (const void*)hymba_fwd, NWAVES * 64, LDS_BYTES) != hipSuccess || per_cu < 1)
            fprintf(stderr, "kernel_launch: note: occupancy query reports %d workgroups per CU\n", per_cu);
        (void)hipGetLastError();
        grid = cus < 256 ? (cus / 8) * 8 : 256;
        if (grid < 8) grid = cus;
    }
    if (grid < 0) return;
    if (hipMemsetAsync((char*)d_ws + WS_CTL, 0, CTL_ZERO_BYTES, stream) != hipSuccess) { fprintf(stderr, "kernel_launch: hipMemsetAsync failed\n"); return; }
    Args a{};
    for (int i = 0; i < 16; ++i) a.in[i] = (const float*)d_in[i];
    a.out = (float*)d_out; a.ws = (unsigned char*)d_ws;
    for (int i = 0; i < 32; ++i) a.inv_freq[i] = (float)pow(10000.0, -(double)i / 32.0);
    const int last = MK_LAST_PHASE < PER_PHASE ? MK_LAST_PHASE : PER_PHASE;
    if (N_LAUNCHES == 1) { a.ph_lo = 0; a.ph_hi = last; a.li = 0; hipLaunchKernelGGL(hymba_fwd, dim3(grid), dim3(NWAVES * 64), LDS_BYTES, stream, a); }
    else for (int li = 0; li < last; ++li) { a.ph_lo = li; a.ph_hi = li + 1; a.li = li; hipLaunchKernelGGL(hymba_fwd, dim3(grid), dim3(NWAVES * 64), LDS_BYTES, stream, a); }
    const hipError_t le = hipPeekAtLastError();
    if (le != hipSuccess) fprintf(stderr, "kernel_launch: launch failed: %s (grid %d)\n", hipGetErrorName(le), grid);
}
```

```cpp
#include <hip/hip_runtime.h>
#include <hip/hip_bf16.h>
#include <cstdio>
#include <cstdint>
#include <cmath>

#ifndef MK_N_LAUNCHES
#define MK_N_LAUNCHES 1
#endif
#ifndef MK_LAST_PHASE
#define MK_LAST_PHASE 9
#endif
constexpr int BATCH = 2, T = 8192, D = 1024, FF = 4096, M = BATCH * T;
constexpr int NH = 8, HD = 64, AW = 512;
constexpr int IN_COLS = 3144, NIN = 3072;
constexpr int SEC_Q = 0, SEC_K = 512, SEC_V = 1024, SEC_QI = 1536, SEC_KI = 2048, SEC_WI = 2112, SEC_GU = 2120, SEC_GV = 2632;
constexpr int TOPK = 256;
constexpr size_t MiB = 1u << 20;
constexpr size_t WS_CTL = 0, CTL_ZERO_BYTES = 1 * MiB;
constexpr size_t CTL_MOD = 64 * 1024;
constexpr size_t CTL_BIAS1 = 128 * 1024;
constexpr int CW_TMO = 0, CW_CODE = 1, CW_KMAX = 8192, CW_DBG = 8256;
constexpr int CW_BAR = 4096;
constexpr size_t WS_WIN = 1 * MiB, WS_WSM = 7 * MiB, WS_WOUT = 8 * MiB, WS_WFF2 = 10 * MiB, WS_WFF1 = 18 * MiB;
constexpr size_t WS_COS = 34 * MiB, WS_SIN = 35 * MiB;
constexpr size_t WS_SSA = 36 * MiB, WS_SSG = 36 * MiB + 512 * 1024, WS_SSX1 = 37 * MiB, WS_SSX2 = 38 * MiB, WS_WI = 39 * MiB, WS_WSP = 39 * MiB + 512 * 1024;
constexpr size_t WS_X1H = 40 * MiB;
constexpr size_t WS_MASK = 40 * MiB, WS_KI = 58 * MiB;
constexpr size_t WS_U = 72 * MiB;
constexpr size_t WS_H1 = 72 * MiB, WS_MRG = 72 * MiB;
constexpr size_t WS_Q = 104 * MiB, WS_K = 120 * MiB, WS_V = 136 * MiB;
constexpr size_t WS_QI = 152 * MiB, WS_GU = 168 * MiB, WS_VN = 184 * MiB;
constexpr size_t WS_END = 200 * MiB;
constexpr int RING_OFF = 0;
constexpr int LDS_BYTES = 163840;
constexpr int LDSCTL_OFF = LDS_BYTES - 1024, MISC_OFF = LDSCTL_OFF + 320;
constexpr int NWAVES = 8;
namespace pg8 {
#define PG8_LAS __attribute__((address_space(3)))
typedef unsigned short bf16_t;
typedef short bf16x8 __attribute__((ext_vector_type(8)));
typedef float f32x4 __attribute__((ext_vector_type(4)));
typedef unsigned u32x4 __attribute__((ext_vector_type(4)));
constexpr int BM = 256, BK = 64, HALF = 128, HTB = HALF * BK * 2  , STAGE_BYTES = 8 * HTB, NXCD = 8, WGM = 8;

__host__ __device__ __forceinline__ int lds_byte(int r, int c) { const int st = (r >> 4) * 2 + (c >> 5), rr = r & 15, cc = c & 31, ob = rr * 64 + cc * 2; return st * 1024 + (ob ^ (((ob >> 9) & 1) << 5)); }
__host__ __device__ __forceinline__ void stage_rc(int b, int& R, int& C) { const int st = b / 1024, sb = b % 1024, swz = sb ^ (((sb >> 9) & 1) << 5); R = (st >> 1) * 16 + swz / 64; C = (st & 1) * 32 + (swz % 64) / 2; }
__host__ __device__ __forceinline__ int perm32(int rho) { const int n = rho >> 4, i = rho & 15; return 8 * (i >> 2) + 4 * n + (i & 3); }

struct Unit { int pm, pn; };
struct Gemm { const bf16_t* A; const bf16_t* Bt; int M, N, K; size_t bbatch; };

struct StaticOrder {
    int nM, nN, nwg, G, c;
    __host__ __device__ void init(int M, int N, int G_, int c_) { nM = M / BM; nN = N / BM; nwg = nM * nN; G = G_; c = c_; }
    __host__ __device__ bool next(int i, Unit& u) const {
        const long L = (long)i * G + c; if (L >= nwg) return false;
        int wgid = (int)L; { const int q = nwg / NXCD, r = nwg % NXCD, xcd = wgid % NXCD, off = wgid / NXCD; wgid = (xcd < r ? xcd * (q + 1) : r * (q + 1) + (xcd - r) * q) + off; }
        const int nig = WGM * nN, gid = wgid / nig, fm = gid * WGM, gsz = (nM - fm) < WGM ? (nM - fm) : WGM;
        u.pm = fm + ((wgid % nig) % gsz); u.pn = (wgid % nig) / gsz; return true;
    }
    __device__ __forceinline__ void a_ready(const Unit&) const {}
    __device__ __forceinline__ void done(const Unit&) const {}
};

typedef float f32x2 __attribute__((ext_vector_type(2)));
typedef _Float16 f16x2 __attribute__((ext_vector_type(2)));
typedef _Float16 f16x8 __attribute__((ext_vector_type(8)));
typedef __bf16 bf16x2v __attribute__((ext_vector_type(2)));
__device__ __forceinline__ unsigned pk_f16(float lo, float hi) { f16x2 v = {(_Float16)lo, (_Float16)hi}; return __builtin_bit_cast(unsigned, v); }
__device__ __forceinline__ unsigned pk_bf16(float lo, float hi) { f32x2 v = {lo, hi}; bf16x2v b = __builtin_convertvector(v, bf16x2v); return __builtin_bit_cast(unsigned, b); }
__device__ __forceinline__ float gelu_tanh(float v) {
    const float y = 0.7978845608028654f * (v + 0.044715f * v * v * v);
    const float e = __builtin_amdgcn_exp2f(-2.8853900817779268f * y);
    return v * __builtin_amdgcn_rcpf(1.0f + e);
}
constexpr float QK_C2 = 0.125f * 1.4426950408889634f;
constexpr float RMS_EPS = 1e-6f;

struct EpiInProj {
    static constexpr bool PERM = true, AFTER_DRAIN = false, MIDK = false;
    unsigned short *Q, *K, *V, *QI, *GU, *VN; const float *cosT, *sinT, *gmg;
    __device__ __forceinline__ void midk(f32x4 (&)[2][2][4][2], const Unit&, int, int, int, int) const {}
    __device__ __forceinline__ void operator()(const f32x4 (&acc)[2][2][4][2], const Unit& u, int wr, int wc, int fr, int fq) const {
        const int sec = u.pn >> 1, head = 4 * (u.pn & 1) + wc, dlo = 8 * fq, colb = head * 64 + dlo;
        unsigned short* dst = sec == 0 ? Q : sec == 1 ? K : sec == 2 ? V : sec == 3 ? QI : sec == 4 ? GU : VN;
        const bool rope = (sec <= 1) || (sec == 3);
        float gl[8], gh[8];
        if (sec == 5) {
#pragma unroll
            for (int e = 0; e < 8; ++e) { gl[e] = gmg[colb + e]; gh[e] = gmg[colb + 32 + e]; }
        }
#pragma unroll
        for (int ai = 0; ai < 2; ++ai)
#pragma unroll
            for (int m = 0; m < 4; ++m) {
                const int row = u.pm * BM + ai * HALF + wr * 64 + m * 16 + fr;
                float lo[8], hi[8];
#pragma unroll
                for (int n = 0; n < 2; ++n)
#pragma unroll
                    for (int j = 0; j < 4; ++j) { lo[4 * n + j] = acc[ai][0][m][n][j]; hi[4 * n + j] = acc[ai][1][m][n][j]; }
                if (rope) {
                    const int pos = row & 8191;
                    const f32x4 c0 = *(const f32x4*)(cosT + pos * 32 + dlo), c1 = *(const f32x4*)(cosT + pos * 32 + dlo + 4);
                    const f32x4 s0 = *(const f32x4*)(sinT + pos * 32 + dlo), s1 = *(const f32x4*)(sinT + pos * 32 + dlo + 4);
                    const float sc = (sec == 0) ? QK_C2 : 1.0f;
#pragma unroll
                    for (int e = 0; e < 8; ++e) { const float c = e < 4 ? c0[e & 3] : c1[e & 3], s = e < 4 ? s0[e & 3] : s1[e & 3];
                        const float a = lo[e], b = hi[e]; lo[e] = (a * c - b * s) * sc; hi[e] = (a * s + b * c) * sc; }
                } else if (sec >= 4) {
#pragma unroll
                    for (int e = 0; e < 8; ++e) { lo[e] = gelu_tanh(lo[e]); hi[e] = gelu_tanh(hi[e]); }
                    if (sec == 5) {
                        float s = 0.f;
#pragma unroll
                        for (int e = 0; e < 8; ++e) s += lo[e] + hi[e];
                        s += __shfl_xor(s, 16); s += __shfl_xor(s, 32);
                        const float mu = s * (1.0f / 64.0f); float q = 0.f;
#pragma unroll
                        for (int e = 0; e < 8; ++e) { lo[e] -= mu; hi[e] -= mu; q += lo[e] * lo[e] + hi[e] * hi[e]; }
                        q += __shfl_xor(q, 16); q += __shfl_xor(q, 32);
                        const float rs = 1.0f / sqrtf(q * (1.0f / 64.0f) + RMS_EPS);
#pragma unroll
                        for (int e = 0; e < 8; ++e) { lo[e] = lo[e] * rs * gl[e]; hi[e] = hi[e] * rs * gh[e]; }
                    }
                }
                u32x4 wl, wh;
                if (sec <= 2) { wl.x = pk_bf16(lo[0], lo[1]); wl.y = pk_bf16(lo[2], lo[3]); wl.z = pk_bf16(lo[4], lo[5]); wl.w = pk_bf16(lo[6], lo[7]);
                                wh.x = pk_bf16(hi[0], hi[1]); wh.y = pk_bf16(hi[2], hi[3]); wh.z = pk_bf16(hi[4], hi[5]); wh.w = pk_bf16(hi[6], hi[7]); }
                else          { wl.x = pk_f16(lo[0], lo[1]); wl.y = pk_f16(lo[2], lo[3]); wl.z = pk_f16(lo[4], lo[5]); wl.w = pk_f16(lo[6], lo[7]);
                                wh.x = pk_f16(hi[0], hi[1]); wh.y = pk_f16(hi[2], hi[3]); wh.z = pk_f16(hi[4], hi[5]); wh.w = pk_f16(hi[6], hi[7]); }
                unsigned short* rp = dst + (size_t)row * 512 + colb;
                *(u32x4*)rp = wl; *(u32x4*)(rp + 32) = wh;
            }
    }
};

__device__ __forceinline__ float rstd_from8(const float* p, float inv_n) {
    const f32x4 a = *(const f32x4*)p, b = *(const f32x4*)(p + 4);
    return 1.0f / sqrtf(((a[0] + a[1]) + (a[2] + a[3]) + (b[0] + b[1]) + (b[2] + b[3])) * inv_n + RMS_EPS);
}
__device__ __forceinline__ float rstd_from16(const float* p, float inv_n) {
    const f32x4 a = *(const f32x4*)p, b = *(const f32x4*)(p + 4), c = *(const f32x4*)(p + 8), d = *(const f32x4*)(p + 12);
    return 1.0f / sqrtf((((a[0] + a[1]) + (a[2] + a[3])) + ((b[0] + b[1]) + (b[2] + b[3])) + ((c[0] + c[1]) + (c[2] + c[3])) + ((d[0] + d[1]) + (d[2] + d[3]))) * inv_n + RMS_EPS);
}

struct EpiOutProj {
    static constexpr bool PERM = true, AFTER_DRAIN = false, MIDK = true;
    const float* x; float* x1; unsigned short* x1h; const float* g1; const PG8_LAS float* rowf; float* ssx1;
    __device__ __forceinline__ void midk(f32x4 (&acc)[2][2][4][2], const Unit& u, int wr, int wc, int fr, int fq) const {
#pragma unroll
        for (int ai = 0; ai < 2; ++ai)
#pragma unroll
            for (int m = 0; m < 4; ++m) {
                const float f = rowf[2 * (ai * HALF + wr * 64 + m * 16 + fr)];
#pragma unroll
                for (int bj = 0; bj < 2; ++bj)
#pragma unroll
                    for (int n = 0; n < 2; ++n) acc[ai][bj][m][n] = acc[ai][bj][m][n] * f;
            }
    }
    __device__ __forceinline__ void operator()(const f32x4 (&acc)[2][2][4][2], const Unit& u, int wr, int wc, int fr, int fq) const {
#pragma unroll
        for (int ai = 0; ai < 2; ++ai)
#pragma unroll
            for (int m = 0; m < 4; ++m) {
                const int rl = ai * HALF + wr * 64 + m * 16 + fr, row = u.pm * BM + rl; const int b = row >> 13;
                const float rg = rowf[2 * rl + 1];
                float ss = 0.f;
#pragma unroll
                for (int bj = 0; bj < 2; ++bj) {
                    const int c0 = u.pn * BM + bj * HALF + wc * 32 + 8 * fq; const size_t off = (size_t)row * 1024 + c0;
                    const f32x4 x0 = *(const f32x4*)(x + off), x1v = *(const f32x4*)(x + off + 4);
                    const f32x4 g0 = *(const f32x4*)(g1 + b * 6144 + c0), g1v = *(const f32x4*)(g1 + b * 6144 + c0 + 4);
                    const f32x4 o0 = x0 + g0 * (acc[ai][bj][m][0] * rg), o1 = x1v + g1v * (acc[ai][bj][m][1] * rg);
                    *(f32x4*)(x1 + off) = o0; *(f32x4*)(x1 + off + 4) = o1;
                    u32x4 w; w.x = pk_f16(o0[0], o0[1]); w.y = pk_f16(o0[2], o0[3]); w.z = pk_f16(o1[0], o1[1]); w.w = pk_f16(o1[2], o1[3]);
                    *(u32x4*)(x1h + off) = w;
                    ss += (o0[0] * o0[0] + o0[1] * o0[1]) + (o0[2] * o0[2] + o0[3] * o0[3]) + (o1[0] * o1[0] + o1[1] * o1[1]) + (o1[2] * o1[2] + o1[3] * o1[3]);
                }
                ss += __shfl_xor(ss, 16); ss += __shfl_xor(ss, 32);
                if (fq == 0) ssx1[(size_t)row * 16 + u.pn * 4 + wc] = ss;
                asm volatile("" ::: "memory");
            }
    }
};
struct SingleOrder { Unit u; __device__ bool next(int i, Unit& o) const { if (i) return false; o = u; return true; }
    __device__ __forceinline__ void a_ready(const Unit&) const {} __device__ __forceinline__ void done(const Unit&) const {} };

struct EpiFF1 {
    static constexpr bool PERM = true, AFTER_DRAIN = false, MIDK = false;
    unsigned short* U; const float* bias1; const float* ssx1;
    __device__ __forceinline__ void midk(f32x4 (&)[2][2][4][2], const Unit&, int, int, int, int) const {}
    __device__ __forceinline__ void operator()(const f32x4 (&acc)[2][2][4][2], const Unit& u, int wr, int wc, int fr, int fq) const {
        const int b = u.pm >> 5;
        f32x4 bv[2][2];
#pragma unroll
        for (int bj = 0; bj < 2; ++bj)
#pragma unroll
            for (int n = 0; n < 2; ++n) bv[bj][n] = *(const f32x4*)(bias1 + b * 4096 + u.pn * BM + bj * HALF + wc * 32 + 8 * fq + 4 * n);
#pragma unroll
        for (int ai = 0; ai < 2; ++ai)
#pragma unroll
            for (int m = 0; m < 4; ++m) {
                const int row = u.pm * BM + ai * HALF + wr * 64 + m * 16 + fr;
                const float r2 = rstd_from16(ssx1 + (size_t)row * 16, 1.0f / 1024.0f);
#pragma unroll
                for (int bj = 0; bj < 2; ++bj) {
                    f32x4 z0 = acc[ai][bj][m][0] * r2 + bv[bj][0], z1 = acc[ai][bj][m][1] * r2 + bv[bj][1];
#pragma unroll
                    for (int j = 0; j < 4; ++j) { const float a = fmaxf(z0[j], 0.f), c = fmaxf(z1[j], 0.f); z0[j] = a * a; z1[j] = c * c; }
                    u32x4 w; w.x = pk_f16(z0[0], z0[1]); w.y = pk_f16(z0[2], z0[3]); w.z = pk_f16(z1[0], z1[1]); w.w = pk_f16(z1[2], z1[3]);
                    *(u32x4*)(U + (size_t)row * 4096 + u.pn * BM + bj * HALF + wc * 32 + 8 * fq) = w;
                }
            }
    }
};

struct EpiFF2 {
    static constexpr bool PERM = true, AFTER_DRAIN = false, MIDK = false;
    float* x1; const float* g2; float* ssx2;
    __device__ __forceinline__ void midk(f32x4 (&)[2][2][4][2], const Unit&, int, int, int, int) const {}
    __device__ __forceinline__ void operator()(const f32x4 (&acc)[2][2][4][2], const Unit& u, int wr, int wc, int fr, int fq) const {
#pragma unroll
        for (int ai = 0; ai < 2; ++ai)
#pragma unroll
            for (int m = 0; m < 4; ++m) {
                const int row = u.pm * BM + ai * HALF + wr * 64 + m * 16 + fr; const int b = row >> 13;
                float ss = 0.f;
#pragma unroll
                for (int bj = 0; bj < 2; ++bj) {
                    const int c0 = u.pn * BM + bj * HALF + wc * 32 + 8 * fq; const size_t off = (size_t)row * 1024 + c0;
                    const f32x4 x0 = *(const f32x4*)(x1 + off), x1v = *(const f32x4*)(x1 + off + 4);
                    const f32x4 g0 = *(const f32x4*)(g2 + b * 6144 + c0), g1v = *(const f32x4*)(g2 + b * 6144 + c0 + 4);
                    const f32x4 o0 = x0 + g0 * acc[ai][bj][m][0], o1 = x1v + g1v * acc[ai][bj][m][1];
                    *(f32x4*)(x1 + off) = o0; *(f32x4*)(x1 + off + 4) = o1;
                    ss += (o0[0] * o0[0] + o0[1] * o0[1]) + (o0[2] * o0[2] + o0[3] * o0[3]) + (o1[0] * o1[0] + o1[1] * o1[1]) + (o1[2] * o1[2] + o1[3] * o1[3]);
                }
                ss += __shfl_xor(ss, 16); ss += __shfl_xor(ss, 32);
                if (fq == 0) ssx2[(size_t)row * 16 + u.pn * 4 + wc] = ss;
            }
    }
};


template <class Epi, class Sched, bool ALIGN_EPI = false, bool SP2 = false>
__device__ __forceinline__ void gemm_phase(PG8_LAS unsigned char* lds, const Gemm g, const Sched& S, const Epi& E) {
    const int tid = threadIdx.x, wid = __builtin_amdgcn_readfirstlane(tid >> 6), lane = tid & 63, wr = wid >> 2, wc = wid & 3, fr = lane & 15, fq = lane >> 4;
    const int K = g.K, nt = K / BK;
    unsigned voffA[2], voffB[2];
#pragma unroll
    for (int i = 0; i < 2; ++i) { int R, C; stage_rc(tid * 16 + i * 8192, R, C); const int Rb = Epi::PERM ? ((R & ~31) + perm32(R & 31)) : R;
        voffA[i] = (unsigned)(R * K + C) * 2u; voffB[i] = (unsigned)(Rb * K + C) * 2u; }
    const size_t kstep = (size_t)(BK * 2);
    const size_t hstep = (size_t)HALF * K * 2;
    const size_t tstep = 2 * hstep;
    const unsigned ldsw = (unsigned)wid * 1024u;
    const int aoff = lds_byte(wr * 64 + fr, fq * 8), boff = lds_byte(wc * 32 + fr, fq * 8);
#define PG8_SA(b, h) (((b) * 2 + (h)) * HTB)
#define PG8_SB(b, h) ((4 + (b) * 2 + (h)) * HTB)
#define PG8_STAGE(bufoff, gbase, voff) do { _Pragma("unroll") for (int _i = 0; _i < 2; ++_i) \
        __builtin_amdgcn_global_load_lds((const unsigned*)((const char*)(gbase) + (voff)[_i]), (PG8_LAS unsigned*)(lds + (bufoff) + ldsw + _i * 8192), 16, 0, 0); } while (0)
#define PG8_LDA(dst, b, h) do { _Pragma("unroll") for (int m = 0; m < 4; ++m) _Pragma("unroll") for (int k = 0; k < 2; ++k) dst[m][k] = *(const PG8_LAS bf16x8*)(lds + PG8_SA(b, h) + aoff + m * 2048 + k * 1024); } while (0)
#define PG8_LDB(dst, b, h) do { _Pragma("unroll") for (int n = 0; n < 2; ++n) _Pragma("unroll") for (int k = 0; k < 2; ++k) dst[n][k] = *(const PG8_LAS bf16x8*)(lds + PG8_SB(b, h) + boff + n * 2048 + k * 1024); } while (0)
#define PG8_MMA(ai, bj, At, Bt) do { __builtin_amdgcn_s_setprio(1); _Pragma("unroll") for (int m = 0; m < 4; ++m) _Pragma("unroll") for (int n = 0; n < 2; ++n) _Pragma("unroll") for (int k = 0; k < 2; ++k) \
        acc[ai][bj][m][n] = __builtin_amdgcn_mfma_f32_16x16x32_f16(__builtin_bit_cast(f16x8, Bt[n][k]), __builtin_bit_cast(f16x8, At[m][k]), acc[ai][bj][m][n], 0, 0, 0); __builtin_amdgcn_s_setprio(0); } while (0)
#define PG8_WAIT_V(n) asm volatile("s_waitcnt vmcnt(" #n ")" ::: "memory")
#define PG8_WAIT_L(n) asm volatile("s_waitcnt lgkmcnt(" #n ")" ::: "memory")
#define PG8_BAR __builtin_amdgcn_s_barrier()
#define PG8_SCHED __builtin_amdgcn_sched_barrier(0)
    Unit cur, nxt; int ui = 0;
    if (!S.next(0, cur)) return;
    f32x4 acc[2][2][4][2];
#pragma unroll
    for (int a = 0; a < 2; ++a)
#pragma unroll
        for (int b = 0; b < 2; ++b)
#pragma unroll
            for (int m = 0; m < 4; ++m)
#pragma unroll
                for (int n = 0; n < 2; ++n) acc[a][b][m][n] = (f32x4){0.f, 0.f, 0.f, 0.f};
    bf16x8 At[4][2], B0[2][2], B1[2][2];
    const char* cA = (const char*)g.A + (size_t)cur.pm * tstep; const char* cB = (const char*)g.Bt + (size_t)cur.pn * tstep + (size_t)(cur.pm >> 5) * g.bbatch;
    S.a_ready(cur);
    if constexpr (SP2) {
        PG8_STAGE(PG8_SB(0, 0), cB, voffB); PG8_STAGE(PG8_SB(0, 1), cB + hstep, voffB); PG8_STAGE(PG8_SA(0, 0), cA, voffA); PG8_STAGE(PG8_SA(0, 1), cA + hstep, voffA);
        if (wr == 1) PG8_BAR;
        PG8_WAIT_V(2); PG8_BAR;
        PG8_STAGE(PG8_SB(1, 0), cB + kstep, voffB); PG8_STAGE(PG8_SA(1, 0), cA + kstep, voffA); PG8_STAGE(PG8_SB(1, 1), cB + hstep + kstep, voffB);
        PG8_WAIT_V(6); PG8_BAR;
    } else {
        PG8_STAGE(PG8_SB(0, 0), cB, voffB); PG8_STAGE(PG8_SA(0, 0), cA, voffA); PG8_STAGE(PG8_SB(0, 1), cB + hstep, voffB); PG8_STAGE(PG8_SA(0, 1), cA + hstep, voffA);
        if (wr == 1) PG8_BAR;
        PG8_WAIT_V(4); PG8_BAR;
        PG8_STAGE(PG8_SB(1, 0), cB + kstep, voffB); PG8_STAGE(PG8_SA(1, 0), cA + kstep, voffA); PG8_STAGE(PG8_SB(1, 1), cB + hstep + kstep, voffB);
        PG8_WAIT_V(6); PG8_BAR;
    }
    for (;;) {
        const bool has_next = S.next(ui + 1, nxt);
        const char* nA = has_next ? (const char*)g.A + (size_t)nxt.pm * tstep : cA; const char* nB = has_next ? (const char*)g.Bt + (size_t)nxt.pn * tstep + (size_t)(nxt.pm >> 5) * g.bbatch : cB;
        for (int t = 0; t < nt; t += 2) {
            if constexpr (Epi::MIDK) { if (t == (nt >> 1)) E.midk(acc, cur, wr, wc, fr, fq); }
            const bool last = (t == nt - 2);
            const char* a1 = cA + (size_t)(t + 1) * kstep;
            const char* a2 = last ? nA : cA + (size_t)(t + 2) * kstep; const char* b2 = last ? nB : cB + (size_t)(t + 2) * kstep;
            const char* a3 = a2 + kstep; const char* b3 = b2 + kstep;
            if (last && has_next) S.a_ready(nxt);
            if constexpr (SP2) {
            PG8_LDB(B0, 0, 0); PG8_LDB(B1, 0, 1); PG8_SCHED; PG8_LDA(At, 0, 0); PG8_STAGE(PG8_SA(1, 1), a1 + hstep, voffA);
            PG8_WAIT_V(8); PG8_WAIT_L(0); PG8_BAR; PG8_MMA(0, 0, At, B0); PG8_MMA(0, 1, At, B1); PG8_BAR; PG8_SCHED;
            PG8_LDA(At, 0, 1); PG8_STAGE(PG8_SB(0, 0), b2, voffB); PG8_STAGE(PG8_SB(0, 1), b2 + hstep, voffB); PG8_STAGE(PG8_SA(0, 0), a2, voffA);
            PG8_WAIT_V(8); PG8_WAIT_L(0); PG8_BAR; PG8_MMA(1, 0, At, B0); PG8_MMA(1, 1, At, B1); PG8_BAR; PG8_SCHED;
            PG8_LDB(B0, 1, 0); PG8_LDB(B1, 1, 1); PG8_SCHED; PG8_LDA(At, 1, 0); PG8_STAGE(PG8_SA(0, 1), a2 + hstep, voffA);
            PG8_WAIT_V(8); PG8_WAIT_L(0); PG8_BAR; PG8_MMA(0, 0, At, B0); PG8_MMA(0, 1, At, B1); PG8_BAR; PG8_SCHED;
            PG8_LDA(At, 1, 1); PG8_STAGE(PG8_SB(1, 0), b3, voffB); PG8_STAGE(PG8_SB(1, 1), b3 + hstep, voffB); PG8_STAGE(PG8_SA(1, 0), a3, voffA);
            PG8_WAIT_V(8); PG8_WAIT_L(0); PG8_BAR; PG8_MMA(1, 0, At, B0); PG8_MMA(1, 1, At, B1); PG8_BAR; PG8_SCHED;
            } else {
            PG8_LDB(B0, 0, 0); PG8_SCHED; PG8_LDA(At, 0, 0); PG8_STAGE(PG8_SA(1, 1), a1 + hstep, voffA);
            PG8_WAIT_L(8); PG8_BAR; PG8_WAIT_L(0); PG8_MMA(0, 0, At, B0); PG8_BAR; PG8_SCHED;
            PG8_LDB(B1, 0, 1); PG8_STAGE(PG8_SB(0, 0), b2, voffB);
            PG8_BAR; PG8_WAIT_L(0); PG8_MMA(0, 1, At, B1); PG8_BAR;
            PG8_LDA(At, 0, 1); PG8_STAGE(PG8_SA(0, 0), a2, voffA);
            PG8_BAR; PG8_WAIT_L(0); PG8_MMA(1, 0, At, B0); PG8_BAR; PG8_SCHED;
            PG8_STAGE(PG8_SB(0, 1), b2 + hstep, voffB);
            PG8_WAIT_V(6); PG8_BAR; PG8_MMA(1, 1, At, B1); PG8_BAR;
            PG8_LDB(B0, 1, 0); PG8_SCHED; PG8_LDA(At, 1, 0); PG8_STAGE(PG8_SA(0, 1), a2 + hstep, voffA);
            PG8_WAIT_L(8); PG8_BAR; PG8_WAIT_L(0); PG8_MMA(0, 0, At, B0); PG8_BAR; PG8_SCHED;
            PG8_LDB(B1, 1, 1); PG8_STAGE(PG8_SB(1, 0), b3, voffB);
            PG8_BAR; PG8_WAIT_L(0); PG8_MMA(0, 1, At, B1); PG8_BAR;
            PG8_LDA(At, 1, 1); PG8_STAGE(PG8_SA(1, 0), a3, voffA);
            PG8_BAR; PG8_WAIT_L(0); PG8_MMA(1, 0, At, B0); PG8_BAR; PG8_SCHED;
            PG8_STAGE(PG8_SB(1, 1), b3 + hstep, voffB);
            PG8_WAIT_V(6); PG8_BAR; PG8_MMA(1, 1, At, B1); PG8_BAR;
            }
        }
        if constexpr (ALIGN_EPI) { if (wr == 0) PG8_BAR; }
        if constexpr (!Epi::AFTER_DRAIN) { E(acc, cur, wr, wc, fr, fq); S.done(cur); }
        if (!has_next) break;
#pragma unroll
        for (int a = 0; a < 2; ++a)
#pragma unroll
            for (int b = 0; b < 2; ++b)
#pragma unroll
                for (int m = 0; m < 4; ++m)
#pragma unroll
                    for (int n = 0; n < 2; ++n) acc[a][b][m][n] = (f32x4){0.f, 0.f, 0.f, 0.f};
        cur = nxt; cA = nA; cB = nB; ++ui;
        if constexpr (ALIGN_EPI) { if (wr == 1) PG8_BAR; }
    }
    PG8_WAIT_V(0);
    if constexpr (!ALIGN_EPI) { if (wr == 0) PG8_BAR; }
    PG8_BAR;
    if constexpr (Epi::AFTER_DRAIN) { E.fused(acc, cur, wr, wc, fr, fq, lds, wid, lane); S.done(cur); }
#undef PG8_SA
#undef PG8_SB
#undef PG8_STAGE
#undef PG8_LDA
#undef PG8_LDB
#undef PG8_MMA
#undef PG8_WAIT_V
#undef PG8_WAIT_L
#undef PG8_BAR
#undef PG8_SCHED
}
}
#include <hip/hip_bf16.h>
#include <cmath>
namespace attn_body {
using bf16=__hip_bfloat16;
using bf16x8=__attribute__((ext_vector_type(8)))short;
using s16x4=__attribute__((ext_vector_type(4)))short;
using f32x16=__attribute__((ext_vector_type(16)))float;
using u32x4=__attribute__((ext_vector_type(4)))unsigned;
constexpr int BATCH=2,NHEAD=8,SEQ=8192,D=64,DM=NHEAD*D,OPITCH=1024;
constexpr int NW=8,QBLK=32,QB=QBLK*NW,KVBLK=64,NQB=SEQ/QB;
constexpr int ATTN_PITCH=DM, ATTN_UNIT_ROWS=QB;
__device__ __forceinline__ int crow(int r,int hi){return (r&3)+8*(r>>2)+4*hi;}
#define SBAR() __builtin_amdgcn_sched_barrier(0)
__device__ __forceinline__ void cmask(f32x16&p0,f32x16&p1,int jb,int qrel,int hi){
  const float NEG=-INFINITY; int kb=64*jb+4*hi;
  #pragma unroll
  for(int r=0;r<16;++r){int kv=kb+(r&3)+8*(r>>2); if(kv>qrel)p0[r]=NEG; if(kv+32>qrel)p1[r]=NEG;}
}

constexpr int NSLOT=3, SLOTB=8192;
constexpr int LDS_K=0, LDS_V=NSLOT*SLOTB, LDS_WS=2*NSLOT*SLOTB, LDS_OST=LDS_WS+NW*64*4, LDS_BYTES=LDS_OST+NW*4096;
constexpr float C2=0.125f*1.4426950408889634f;
__device__ __forceinline__ void glds16(const void*gsrc,unsigned lds_dst){unsigned keep;
  asm volatile("s_mov_b32 %0, m0\n\ts_mov_b32 m0, %2\n\ts_nop 0\n\tglobal_load_lds_dwordx4 %1, off\n\ts_mov_b32 m0, %0":"=&s"(keep):"v"(gsrc),"s"(lds_dst):"memory");}
__device__ __forceinline__ float max3f(float a,float b,float c){float r;asm("v_max3_f32 %0, %1, %2, %3":"=v"(r):"v"(a),"v"(b),"v"(c));return r;}
__device__ __forceinline__ float max2f(float a,float b){float r;asm("v_max_f32_e32 %0, %1, %2":"=v"(r):"v"(a),"v"(b));return r;}
__device__ __forceinline__ float fadd_s(float a,float b){float r;asm("v_add_f32_e32 %0, %1, %2":"=v"(r):"v"(a),"v"(b));return r;}
__device__ __forceinline__ float fsub_s(float a,float b){float r;asm("v_sub_f32_e32 %0, %1, %2":"=v"(r):"v"(a),"v"(b));return r;}
typedef float f32x2_t __attribute__((ext_vector_type(2))); typedef __bf16 bf16x2_t __attribute__((ext_vector_type(2)));
__device__ __forceinline__ unsigned cvtpk_s(float lo,float hi){f32x2_t v={lo,hi};bf16x2_t b=__builtin_convertvector(v,bf16x2_t);return __builtin_bit_cast(unsigned,b);}
#define WAIT_BAR(N) asm volatile("s_waitcnt vmcnt(" #N ") lgkmcnt(0)\n\ts_barrier":::"memory")

__device__ __forceinline__ void qkt(f32x16&p0,f32x16&p1,const char*Kslot,const bf16x8*qr,const f32x16&negm,int r32,int hi){
  const char*kb=Kslot+hi*1024+r32*16;
  #pragma unroll
  for(int d0=0;d0<4;++d0){
    const bf16x8 b0=*reinterpret_cast<const bf16x8*>(kb+d0*2048);
    const bf16x8 b1=*reinterpret_cast<const bf16x8*>(kb+d0*2048+512);
    if(d0==0){p0=__builtin_amdgcn_mfma_f32_32x32x16_bf16(b0,qr[0],negm,0,0,0);p1=__builtin_amdgcn_mfma_f32_32x32x16_bf16(b1,qr[0],negm,0,0,0);}
    else{p0=__builtin_amdgcn_mfma_f32_32x32x16_bf16(b0,qr[d0],p0,0,0,0);p1=__builtin_amdgcn_mfma_f32_32x32x16_bf16(b1,qr[d0],p1,0,0,0);}}
}
typedef __attribute__((address_space(3))) const char* lds_cptr;
typedef short v4i16_t __attribute__((ext_vector_type(4)));
__device__ __forceinline__ void kload8(bf16x8*kf,lds_cptr kp){
  kf[0]=*(const __attribute__((address_space(3))) bf16x8*)(kp);      kf[1]=*(const __attribute__((address_space(3))) bf16x8*)(kp+512);
  kf[2]=*(const __attribute__((address_space(3))) bf16x8*)(kp+2048); kf[3]=*(const __attribute__((address_space(3))) bf16x8*)(kp+2560);
  kf[4]=*(const __attribute__((address_space(3))) bf16x8*)(kp+4096); kf[5]=*(const __attribute__((address_space(3))) bf16x8*)(kp+4608);
  kf[6]=*(const __attribute__((address_space(3))) bf16x8*)(kp+6144); kf[7]=*(const __attribute__((address_space(3))) bf16x8*)(kp+6656);
}
__device__ __forceinline__ void kload2(bf16x8*kf,lds_cptr kp,int j){ kf[2*j]=*(const __attribute__((address_space(3))) bf16x8*)(kp+j*2048); kf[2*j+1]=*(const __attribute__((address_space(3))) bf16x8*)(kp+j*2048+512); }
__device__ __forceinline__ s16x4 vtr(lds_cptr p){ return __builtin_bit_cast(s16x4,__builtin_amdgcn_ds_read_tr16_b64_v4i16((__attribute__((address_space(3))) v4i16_t*)p)); }
__device__ __forceinline__ float rowmax(const f32x16&p0,const f32x16&p1){
  float a=max3f(p0[0],p0[1],p1[0]),b=max3f(p0[2],p0[3],p1[1]);a=max3f(a,p1[2],p1[3]);
  #pragma unroll
  for(int r=4;r<16;r+=4){a=max3f(a,p0[r],p0[r+1]);b=max3f(b,p0[r+2],p0[r+3]);a=max3f(a,p1[r],p1[r+1]);b=max3f(b,p1[r+2],p1[r+3]);}
  const float m=max2f(a,b);
  auto rr=__builtin_amdgcn_permlane32_swap(__float_as_uint(m),__float_as_uint(m),false,false);
  return max2f(__uint_as_float(rr[0]),__uint_as_float(rr[1]));
}
__device__ __forceinline__ void pv(f32x16*o,int vb,bf16x8 pa0,bf16x8 pa1,bf16x8 pa2,bf16x8 pa3){
  #pragma unroll
  for(int d0=0;d0<2;++d0){s16x4 lo[4],hi[4];
    #pragma unroll
    for(int ks=0;ks<4;++ks){
      asm volatile("ds_read_b64_tr_b16 %0,%1 offset:%c2":"=&v"(lo[ks]):"v"(vb),"i"(d0*4096+ks*1024):"memory");
      asm volatile("ds_read_b64_tr_b16 %0,%1 offset:%c2":"=&v"(hi[ks]):"v"(vb),"i"(d0*4096+ks*1024+512):"memory");}
    asm volatile("s_waitcnt lgkmcnt(0)":::"memory");SBAR();
    #define PK(k) (bf16x8){lo[k][0],lo[k][1],lo[k][2],lo[k][3],hi[k][0],hi[k][1],hi[k][2],hi[k][3]}
    o[d0]=__builtin_amdgcn_mfma_f32_32x32x16_bf16(pa0,PK(0),o[d0],0,0,0);
    o[d0]=__builtin_amdgcn_mfma_f32_32x32x16_bf16(pa1,PK(1),o[d0],0,0,0);
    o[d0]=__builtin_amdgcn_mfma_f32_32x32x16_bf16(pa2,PK(2),o[d0],0,0,0);
    o[d0]=__builtin_amdgcn_mfma_f32_32x32x16_bf16(pa3,PK(3),o[d0],0,0,0);
    #undef PK
  }
}

#ifndef ATTN_STORE16
#define ATTN_STORE16(p,v) (*(u32x4*)(p)=(v))
#endif
__device__ __forceinline__ float mskf(float v,unsigned w,int bit){ return __uint_as_float(__float_as_uint(v)&(unsigned)(((int)(w<<(31-bit)))>>31)); }
#define WAIT_BARM(N,R) asm volatile("s_waitcnt vmcnt(" #N ") lgkmcnt(0)\n\ts_barrier":"+v"(R)::"memory")
template<int THRL> __device__ __forceinline__ void attn_unit(int b,int h,int qb,const bf16*Q,const bf16*__restrict__ K,const bf16*__restrict__ V,unsigned short*O,const unsigned*MV,float*SSA,char*shm){
  const int tid=threadIdx.x,lane=tid&63,r32=lane&31,hi=lane>>5; const int wid=__builtin_amdgcn_readfirstlane(tid>>6);
  const long rowbase=(long)b*SEQ; const int q0=qb*QB;
  const bf16*Qw=Q+(rowbase+q0+wid*QBLK)*DM+h*D;
  const bf16*Kh=K+rowbase*DM+h*D,*Vh=V+rowbase*DM+h*D;
  const unsigned lds0=(unsigned)(uintptr_t)shm;
  float*wsf=(float*)(shm+LDS_WS)+wid*64;
  const bf16*ksrc=Kh+(long)lane*DM+wid*8;
  const bf16*vsrc=Vh+(long)(16*(wid&3)+(lane>>2))*DM+(wid>>2)*32+(lane&3)*8;
  const unsigned kdst=lds0+LDS_K+wid*1024, vdst=lds0+LDS_V+wid*1024;
  #define DMA_K(t,slot) glds16(ksrc+(long)(t)*KVBLK*DM,(unsigned)__builtin_amdgcn_readfirstlane(kdst+(slot)))
  #define DMA_V(t,slot) glds16(vsrc+(long)(t)*KVBLK*DM,(unsigned)__builtin_amdgcn_readfirstlane(vdst+(slot)))
  const int vb0=(int)(lds0+LDS_V)+((lane>>4)&1)*32+(lane&3)*8+(4*hi+((lane&15)>>2))*64;
  const char*Kbase=shm+LDS_K; bf16x8 kf[8];
  const lds_cptr shm3=(lds_cptr)shm; const lds_cptr kp0=shm3+LDS_K+hi*1024+r32*16; const lds_cptr vp0=shm3+LDS_V+((lane>>4)&1)*32+(lane&3)*8+(4*hi+((lane&15)>>2))*64;
  const int NT=(q0+QB)/KVBLK;
  DMA_K(0,0);DMA_V(0,0);DMA_K(1,SLOTB);
  bf16x8 qr[4];
  #pragma unroll
  for(int d0=0;d0<4;++d0)qr[d0]=*reinterpret_cast<const bf16x8*>(&Qw[(long)r32*DM+d0*16+hi*8]);
  float mhat=0.f,l_reg=0.f;f32x16 o[2];o[0]=f32x16{};o[1]=f32x16{};f32x16 negm=f32x16{};asm volatile("":"+v"(negm));
  const unsigned*mwb; { const unsigned long long pb_=(unsigned long long)(MV+((size_t)((b*256+(q0>>5)+wid)*128))*64); mwb=(const unsigned*)(((unsigned long long)(unsigned)__builtin_amdgcn_readfirstlane((int)(pb_>>32))<<32)|(unsigned)__builtin_amdgcn_readfirstlane((int)pb_)); }
  unsigned mwc=mwb[lane],mwn=0u;
  #define CMASK(P0,P1,t) do{}while(0)
  bool resc=false;
  #define START(P0,P1) do{ const float rm=rowmax(P0,P1); resc=false; \
    { const float dl=rm; mhat=fadd_s(mhat,dl); \
      _Pragma("unroll") for(int r=0;r<16;++r){P0[r]=fsub_s(P0[r],dl);P1[r]=fsub_s(P1[r],dl);} \
      _Pragma("unroll") for(int r=0;r<16;++r)negm[r]=-mhat; asm volatile("":"+v"(negm)); } \
    _Pragma("unroll") for(int r=0;r<16;++r)P0[r]=mskf(__builtin_amdgcn_exp2f(P0[r]),mwc,r); }while(0)
  #define RESC() do{ if(resc){ asm volatile("s_waitcnt lgkmcnt(0)":::"memory"); \
      _Pragma("unroll") for(int d_=0;d_<2;++d_) _Pragma("unroll") for(int r=0;r<16;++r)o[d_][r]*=wsf[crow(r,hi)]; } }while(0)
  f32x16 pA0,pA1,pB0,pB1;
  int sl_prev=0,sl_cur=0,sl_next=SLOTB;
  #define ROT() do{sl_prev=sl_cur;sl_cur=sl_next;sl_next=(sl_next==(NSLOT-1)*SLOTB)?0:sl_next+SLOTB;}while(0)
  DMA_K(2,2*SLOTB);
  WAIT_BAR(3);
  qkt(pA0,pA1,Kbase,qr,negm,r32,hi);asm volatile("s_nop 15\n\ts_nop 7":"+v"(pA0),"+v"(pA1));CMASK(pA0,pA1,0);
  START(pA0,pA1);
  _Pragma("unroll") for(int r=0;r<16;++r)pA1[r]=mskf(__builtin_amdgcn_exp2f(pA1[r]),mwc,16+r);
  WAIT_BAR(0);
  { const unsigned*mp_=mwb+64; const unsigned l4_=(unsigned)lane*4u; asm volatile("global_load_dword %0, %1, %2":"=v"(mwn):"v"(l4_),"s"(mp_):"memory"); }
  DMA_K(3,0);DMA_V(1,SLOTB);
  ROT();
  kload8(kf,kp0+sl_cur);
  WAIT_BARM(2,mwn); mwc=mwn;
  s16x4 vlo[8],vhi[8]; u32x4 pw0,pw1,pw2,pw3;
  #define PKW(P,B) cvtpk_s(P[B],P[B+1])
  #define PAF(k) __builtin_bit_cast(bf16x8,pw##k)
  #define VFR(i) (bf16x8){vlo[i][0],vlo[i][1],vlo[i][2],vlo[i][3],vhi[i][0],vhi[i][1],vhi[i][2],vhi[i][3]}
  #define PIN(x) asm volatile("":"+v"(x))
  #define MX3(a,b,c) __builtin_fmaxf(__builtin_fmaxf((a),(b)),(c))
  #define GAPA(MF,A0,A1,A2,A3,W0,W1,PW) do{ MF; sacc+=A0; sacc+=A1; sacc+=A2; sacc+=A3; PIN(sacc); W0; W1; PIN(PW); SBAR(); }while(0)
  #define EX(v) __builtin_amdgcn_exp2f(v)
  #define GAPB(MF,X,B,MB) do{ MF; X[B]=mskf(EX(X[B]),mwc_,MB+B); X[B+1]=mskf(EX(X[B+1]),mwc_,MB+B+1); X[B+2]=mskf(EX(X[B+2]),mwc_,MB+B+2); X[B+3]=mskf(EX(X[B+3]),mwc_,MB+B+3); PIN(X); SBAR(); }while(0)
  #define VRD(i) do{ vlo[i]=vtr(vp_+(((i)>>2)*4096+((i)&3)*1024)); vhi[i]=vtr(vp_+(((i)>>2)*4096+((i)&3)*1024+512)); }while(0)
  #define KRD(G,j) do{ if(G){ kload2(kf,kp0+sl_next,j); SBAR(); } }while(0)
  #define STEP(C0,C1,P0,P1,t,GK,GV,GL,GM) do{ SBAR(); \
    if(GM){ const unsigned*mp_=mwb+(size_t)((t)+1)*64; const unsigned l4_=(unsigned)lane*4u; asm volatile("global_load_dword %0, %1, %2":"=v"(mwn):"v"(l4_),"s"(mp_):"memory"); } const unsigned mwc_=mwc; \
    const lds_cptr vp_=vp0+sl_prev; \
    VRD(0); SBAR(); float sacc=(P0[0]+P0[1]); \
    GAPA(C0=__builtin_amdgcn_mfma_f32_32x32x16_bf16(kf[0],qr[0],negm,0,0,0), P0[2],P0[3],P0[4],P0[5],     pw0[0]=PKW(P0,0), pw0[1]=PKW(P0,2), pw0); \
    VRD(4); SBAR(); GAPA(C1=__builtin_amdgcn_mfma_f32_32x32x16_bf16(kf[1],qr[0],negm,0,0,0), P0[6],P0[7],P0[8],P0[9],     pw0[2]=PKW(P0,4), pw0[3]=PKW(P0,6), pw0); \
    VRD(1); SBAR(); GAPA(C0=__builtin_amdgcn_mfma_f32_32x32x16_bf16(kf[2],qr[1],C0,0,0,0),   P0[10],P0[11],P0[12],P0[13], pw1[0]=PKW(P0,8), pw1[1]=PKW(P0,10), pw1); \
    VRD(5); SBAR(); GAPA(C1=__builtin_amdgcn_mfma_f32_32x32x16_bf16(kf[3],qr[1],C1,0,0,0),   P0[14],P0[15],P1[0],P1[1],   pw1[2]=PKW(P0,12),pw1[3]=PKW(P0,14), pw1); \
    VRD(2); SBAR(); GAPA(C0=__builtin_amdgcn_mfma_f32_32x32x16_bf16(kf[4],qr[2],C0,0,0,0),   P1[2],P1[3],P1[4],P1[5],     pw2[0]=PKW(P1,0), pw2[1]=PKW(P1,2), pw2); \
    VRD(6); SBAR(); GAPA(C1=__builtin_amdgcn_mfma_f32_32x32x16_bf16(kf[5],qr[2],C1,0,0,0),   P1[6],P1[7],P1[8],P1[9],     pw2[2]=PKW(P1,4), pw2[3]=PKW(P1,6), pw2); \
    VRD(3); SBAR(); GAPA(C0=__builtin_amdgcn_mfma_f32_32x32x16_bf16(kf[6],qr[3],C0,0,0,0),   P1[10],P1[11],P1[12],P1[13], pw3[0]=PKW(P1,8), pw3[1]=PKW(P1,10), pw3); \
    VRD(7); SBAR(); GAPA(C1=__builtin_amdgcn_mfma_f32_32x32x16_bf16(kf[7],qr[3],C1,0,0,0),   P1[14],P1[15],0.f,0.f,       pw3[2]=PKW(P1,12),pw3[3]=PKW(P1,14), pw3); \
    l_reg+=sacc; \
    if(GK){DMA_K((t)+3,sl_cur);} if(GV){DMA_V((t)+1,sl_next);} \
    CMASK(C0,C1,t); \
    { float a=MX3(C0[0],C0[1],C1[0]),b=MX3(C0[2],C0[3],C1[1]); a=MX3(a,C1[2],C1[3]); \
      _Pragma("unroll") for(int r=4;r<16;r+=4){a=MX3(a,C0[r],C0[r+1]);b=MX3(b,C0[r+2],C0[r+3]);a=MX3(a,C1[r],C1[r+1]);b=MX3(b,C1[r+2],C1[r+3]);} \
      float rm=__builtin_fmaxf(a,b); { auto rr=__builtin_amdgcn_permlane32_swap(__float_as_uint(rm),__float_as_uint(rm),false,false); rm=__builtin_fmaxf(__uint_as_float(rr[0]),__uint_as_float(rr[1])); } \
      resc=false; \
      if(__builtin_expect(__any(rm>(float)THRL),0)){ const float dl=__builtin_fmaxf(rm,0.f); mhat+=dl; \
        _Pragma("unroll") for(int r=0;r<16;++r){C0[r]-=dl;C1[r]-=dl;} \
        _Pragma("unroll") for(int r=0;r<16;++r)negm[r]=-mhat; asm volatile("":"+v"(negm)); \
        const float f=__builtin_amdgcn_exp2f(-dl); l_reg*=f; if(hi==0)wsf[r32]=f; resc=true; } } \
    SBAR(); \
    GAPB(o[0]=__builtin_amdgcn_mfma_f32_32x32x16_bf16(PAF(0),VFR(0),o[0],0,0,0), C0,0,0); \
    GAPB(o[1]=__builtin_amdgcn_mfma_f32_32x32x16_bf16(PAF(0),VFR(4),o[1],0,0,0), C0,4,0); \
    KRD(GL,0); GAPB(o[0]=__builtin_amdgcn_mfma_f32_32x32x16_bf16(PAF(1),VFR(1),o[0],0,0,0), C0,8,0); \
    KRD(GL,1); GAPB(o[1]=__builtin_amdgcn_mfma_f32_32x32x16_bf16(PAF(1),VFR(5),o[1],0,0,0), C0,12,0); \
    KRD(GL,2); GAPB(o[0]=__builtin_amdgcn_mfma_f32_32x32x16_bf16(PAF(2),VFR(2),o[0],0,0,0), C1,0,16); \
    KRD(GL,3); GAPB(o[1]=__builtin_amdgcn_mfma_f32_32x32x16_bf16(PAF(2),VFR(6),o[1],0,0,0), C1,4,16); \
    GAPB(o[0]=__builtin_amdgcn_mfma_f32_32x32x16_bf16(PAF(3),VFR(3),o[0],0,0,0), C1,8,16); \
    GAPB(o[1]=__builtin_amdgcn_mfma_f32_32x32x16_bf16(PAF(3),VFR(7),o[1],0,0,0), C1,12,16); \
    }while(0)
  int t=1;
  #undef CMASK
  #define CMASK(P0,P1,t) do{}while(0)
  for(;t+5<NT;t+=2){
    STEP(pB0,pB1,pA0,pA1,t,true,true,true,true);     WAIT_BARM(2,mwn); mwc=mwn; RESC(); ROT();
    STEP(pA0,pA1,pB0,pB1,t+1,true,true,true,true);   WAIT_BARM(2,mwn); mwc=mwn; RESC(); ROT();
  }
  #undef CMASK
  #define CMASK(P0,P1,t) do{}while(0)
  #define ENDW(tt) do{ if((tt)+3<NT){WAIT_BARM(2,mwn);} else if((tt)+2<NT){WAIT_BARM(1,mwn);} else {WAIT_BARM(0,mwn);} mwc=mwn; }while(0)
  for(;t+1<NT;t+=2){
    STEP(pB0,pB1,pA0,pA1,t,(t+3<NT),(t+1<NT),(t+1<NT),true);       ENDW(t);   RESC(); ROT();
    STEP(pA0,pA1,pB0,pB1,t+1,(t+4<NT),(t+2<NT),(t+2<NT),true);     ENDW(t+1); RESC(); ROT();
  }
  STEP(pB0,pB1,pA0,pA1,NT-1,false,false,false,false); RESC();
  { float sacc=pB0[0]+pB0[1]; _Pragma("unroll") for(int r=2;r<16;++r)sacc+=pB0[r]; _Pragma("unroll") for(int r=0;r<16;++r)sacc+=pB1[r]; l_reg+=sacc;
    pw0=(u32x4){PKW(pB0,0),PKW(pB0,2),PKW(pB0,4),PKW(pB0,6)};pw1=(u32x4){PKW(pB0,8),PKW(pB0,10),PKW(pB0,12),PKW(pB0,14)};pw2=(u32x4){PKW(pB1,0),PKW(pB1,2),PKW(pB1,4),PKW(pB1,6)};pw3=(u32x4){PKW(pB1,8),PKW(pB1,10),PKW(pB1,12),PKW(pB1,14)};
    SBAR(); pv(o,vb0+sl_cur,PAF(0),PAF(1),PAF(2),PAF(3)); }
  #undef PKW
  #undef PAF
  #undef VFR
  #undef PIN
  #undef MX3
  #undef GAPA
  #undef GAPB
  #undef EX
  #undef VRD
  #undef KRD
  #undef STEP
  #undef ENDW
  {auto rr=__builtin_amdgcn_permlane32_swap(__float_as_uint(l_reg),__float_as_uint(l_reg),false,false);l_reg=__uint_as_float(rr[0])+__uint_as_float(rr[1]);}
  if(hi==0)wsf[32+r32]=l_reg;asm volatile("s_waitcnt lgkmcnt(0)":::"memory");
  float rli[16];
  #pragma unroll
  for(int r=0;r<16;++r)rli[r]=__builtin_amdgcn_rcpf(wsf[32+crow(r,hi)]);
  unsigned short*Ow=O+(rowbase+q0+wid*QBLK)*(long)OPITCH+h*D; float*SSw=SSA+(rowbase+q0+wid*QBLK)*8+h;
  { _Float16*stg=(_Float16*)(shm+LDS_OST)+wid*2048;
    #pragma unroll
    for(int r=0;r<16;++r){const int orow=crow(r,hi);
      #pragma unroll
      for(int d0=0;d0<2;++d0)stg[orow*64+d0*32+r32]=(_Float16)(o[d0][r]*rli[r]);}
    asm volatile("s_waitcnt lgkmcnt(0)":::"memory");
    int ln2=lane; asm volatile("":"+v"(ln2));
    #pragma unroll
    for(int i=0;i<4;++i){const int row=i*8+(ln2>>3),ch=ln2&7; const u32x4 v=*(const u32x4*)(stg+row*64+ch*8); ATTN_STORE16(Ow+(long)row*OPITCH+ch*8,v);
      typedef _Float16 h8_t __attribute__((ext_vector_type(8))); const h8_t hv=__builtin_bit_cast(h8_t,v); float ss=0.f;
      _Pragma("unroll") for(int e=0;e<8;++e){const float f=(float)hv[e]; ss+=f*f;}
      ss+=__shfl_xor(ss,1); ss+=__shfl_xor(ss,2); ss+=__shfl_xor(ss,4); if(ch==0)SSw[(long)row*8]=ss; } }
  asm volatile("s_waitcnt lgkmcnt(0)\n\ts_barrier":::"memory");
  #undef DMA_K
  #undef DMA_V
  #undef CMASK
  #undef START
  #undef RESC
  #undef ROT
}
constexpr int ATTN_LDS_BYTES=LDS_BYTES;
struct AttnTensors { const bf16* Q; const bf16* K; const bf16* V; unsigned short* O; const unsigned* MV; float* SSA; };
struct AttnUnit { int bh; int qb; };
struct StaticOrder {
  int vcu;
  __device__ __forceinline__ explicit StaticOrder(int grid,int block):vcu((block%8)*(grid/8)+block/8){}
  __device__ __forceinline__ bool next(int i,AttnUnit&u)const{ if(i>=2)return false; const int s=vcu&15; u.bh=vcu>>4; u.qb=(i==0)?31-s:s; return true; }
  __device__ __forceinline__ void a_ready(const AttnUnit&)const{}
  __device__ __forceinline__ void done(const AttnUnit&)const{}
};
template<class Sched,int THRL=8> __device__ __forceinline__ void attn_phase(char*lds,const AttnTensors&T,const Sched&S){
  AttnUnit u;
  for(int i=0;S.next(i,u);++i){ S.a_ready(u); attn_unit<THRL>(u.bh/NHEAD,u.bh%NHEAD,u.qb,T.Q,T.K,T.V,T.O,T.MV,T.SSA,lds); S.done(u); }
}
#undef SBAR
#undef WAIT_BAR
}
#define GAS __attribute__((address_space(1)))
#define LAS __attribute__((address_space(3)))
typedef unsigned short bf16;
typedef unsigned v4u __attribute__((ext_vector_type(4)));
typedef float f32x4 __attribute__((ext_vector_type(4)));
typedef short bf16x8 __attribute__((ext_vector_type(8)));
typedef GAS unsigned gu32;
typedef GAS unsigned long long gu64;
#define RLX_AGENT __ATOMIC_RELAXED, __HIP_MEMORY_SCOPE_AGENT
#define LDS_WAIT() asm volatile("s_waitcnt lgkmcnt(0)" ::: "memory")
#define VM_WAIT() asm volatile("s_waitcnt vmcnt(0)" ::: "memory")
__device__ __forceinline__ unsigned long long rt() { return __builtin_amdgcn_s_memrealtime(); }
__device__ __forceinline__ unsigned f2bf(float f) { unsigned u = __builtin_bit_cast(unsigned, f); return (u + 0x7fffu + ((u >> 16) & 1u)) >> 16; }
__device__ __forceinline__ unsigned pk2(float lo, float hi) { return f2bf(lo) | (f2bf(hi) << 16); }

#define XB_TMO      128
#define XB_XCNT(j)  (256  + 64 * (j))
#define XB_XSUB(j)  (1280 + 64 * (j))
#define XB_XGEN(j)  (2304 + 64 * (j))
#define XB_TOP      3328
#define XB_TOPGEN   3392
#define XCD_BAR_WORDS 3456
#define XB_SPIN_CAP (1u << 18)

__device__ __forceinline__ unsigned xb_ld(unsigned* p)              { return __hip_atomic_load(p, __ATOMIC_RELAXED, __HIP_MEMORY_SCOPE_AGENT); }
__device__ __forceinline__ unsigned xb_add(unsigned* p, unsigned v) { return __hip_atomic_fetch_add(p, v, __ATOMIC_RELAXED, __HIP_MEMORY_SCOPE_AGENT); }
__device__ __forceinline__ unsigned xb_xcc_id() { return (unsigned)__builtin_amdgcn_s_getreg((3 << 11) | 20) & 0xFu; }
#define XB_SPIN(cond, bar) do { unsigned _sp = 0; while (cond) { __builtin_amdgcn_s_sleep(1); \
    if ((++_sp & 255u) == 0u) { if (xb_ld(&(bar)[XB_TMO])) break; if (_sp > XB_SPIN_CAP) { atomicAdd(&(bar)[XB_TMO], 1u); break; } } } } while (0)

struct XcdBarrier {
    unsigned* bar; unsigned x;
    volatile LAS unsigned* st;
};

__device__ __forceinline__ XcdBarrier xcd_barrier_post(unsigned* bar, volatile LAS unsigned* st) {
    XcdBarrier b; b.bar = bar; b.x = xb_xcc_id(); b.st = st;
    if (threadIdx.x == 0) (void)xb_add(&bar[XB_XCNT(b.x)], 1u);
    return b;
}
__device__ __forceinline__ void xcd_barrier_complete(unsigned* bar, unsigned x, unsigned& nloc, unsigned& nx) {
    const unsigned G = gridDim.x * gridDim.y * gridDim.z;
    unsigned sum, cnt, mine, sp = 0u;
    for (;;) {
        sum = 0u; cnt = 0u; mine = 0u;
#pragma unroll
        for (unsigned j = 0; j < 16; ++j) { const unsigned c = xb_ld(&bar[XB_XCNT(j)]); sum += c; cnt += (c > 0u) ? 1u : 0u; mine = (j == x) ? c : mine; }
        if (sum == G) break;
        __builtin_amdgcn_s_sleep(1);
        if ((++sp & 255u) == 0u) { if (xb_ld(&bar[XB_TMO])) break; if (sp > XB_SPIN_CAP) { atomicAdd(&bar[XB_TMO], 1u); break; } }
    }
    nloc = mine > 0u ? mine : 1u; nx = cnt > 0u ? cnt : 1u;
}

__device__ __forceinline__ void xcd_barrier(const XcdBarrier& b) {
    asm volatile("s_waitcnt vmcnt(0)" ::: "memory");
    __syncthreads();
    if (threadIdx.x == 0) {
        unsigned* bar = b.bar;
        __builtin_amdgcn_s_waitcnt(0);
        unsigned nloc = b.st[0], nx = b.st[1];
        if (nloc == 0u) { xcd_barrier_complete(bar, b.x, nloc, nx); b.st[0] = nloc; b.st[1] = nx; }
        const unsigned old = xb_add(&bar[XB_XSUB(b.x)], 1u);
        const unsigned gen = old / nloc;
        if (old + 1u == (gen + 1u) * nloc) {
            __builtin_amdgcn_fence(__ATOMIC_RELEASE, "agent");
            asm volatile("s_waitcnt vmcnt(0)" ::: "memory");
            const unsigned og = xb_add(&bar[XB_TOP], 1u);
            const unsigned tg = og / nx;
            if (og + 1u == (tg + 1u) * nx) xb_add(&bar[XB_TOPGEN], 1u);
            else XB_SPIN(xb_ld(&bar[XB_TOPGEN]) == tg, bar);
            __builtin_amdgcn_fence(__ATOMIC_ACQUIRE, "agent");
            xb_add(&bar[XB_XGEN(b.x)], 1u);
            asm volatile("s_waitcnt vmcnt(0)" ::: "memory");
        } else {
            XB_SPIN(xb_ld(&bar[XB_XGEN(b.x)]) == gen, bar);
            __builtin_amdgcn_fence(__ATOMIC_ACQUIRE, "agent");
            asm volatile("s_waitcnt vmcnt(0)" ::: "memory");
        }
    }
    __syncthreads();
}
typedef _Float16 f16x2_t __attribute__((ext_vector_type(2)));
typedef _Float16 h8 __attribute__((ext_vector_type(8)));
typedef float f32x16 __attribute__((ext_vector_type(16)));
struct Args { const float* in[16]; float* out; unsigned char* ws; float inv_freq[32]; int ph_lo, ph_hi, li, pad; };
struct Frame {
    LAS unsigned char* lds; volatile LAS unsigned* MISC; gu32* ctl;
    int tid, lane, wave, vcu, G;
    unsigned char* ws;
};
__device__ __forceinline__ float wave_sum(float v) {
#pragma unroll
    for (int o = 1; o < 64; o <<= 1) v += __shfl_xor(v, o);
    return v;
}
__device__ __forceinline__ float ld_agent(const float* p) { return __hip_atomic_load(p, __ATOMIC_RELAXED, __HIP_MEMORY_SCOPE_AGENT); }
__device__ __forceinline__ unsigned pkh(float lo, float hi) { return pg8::pk_f16(lo, hi); }

__device__ __forceinline__ void tr_item64(const float* W, int ldw, int K, int k0, int src0, int src1, unsigned short* WT, int dst_row0, const float* ks0, const float* ks1, LAS float* scr, int lane) {
    const int c4 = lane & 15, col = (c4 < 8) ? src0 + 4 * c4 : src1 + 4 * (c4 - 8);
    f32x4 v[16];
#pragma unroll
    for (int i = 0; i < 16; ++i) v[i] = *(const GAS f32x4*)(W + (size_t)(k0 + 4 * i + (lane >> 4)) * ldw + col);
#pragma unroll
    for (int i = 0; i < 16; ++i) { const int row = 4 * i + (lane >> 4); f32x4 t = v[i];
        if (ks0) { float sc = ks0[k0 + row]; if (ks1) sc *= 1.0f + ld_agent(ks1 + k0 + row); t = t * sc; }
        LAS float* d = scr + row * 65 + 4 * c4; d[0] = t.x; d[1] = t.y; d[2] = t.z; d[3] = t.w; }
    LDS_WAIT(); asm volatile("" ::: "memory");
    const int c = lane & 7;
#pragma unroll
    for (int j = 0; j < 8; ++j) { const int n = (lane >> 3) + 8 * j; const LAS float* s = scr + (8 * c) * 65 + n;
        v4u o; o.x = pkh(s[0 * 65], s[1 * 65]); o.y = pkh(s[2 * 65], s[3 * 65]); o.z = pkh(s[4 * 65], s[5 * 65]); o.w = pkh(s[6 * 65], s[7 * 65]);
        *(GAS v4u*)(WT + (size_t)(dst_row0 + n) * K + k0 + 8 * c) = o; }
    LDS_WAIT(); asm volatile("" ::: "memory");
}
__device__ __forceinline__ void gemv_item(const float* Wm, int ldw, int k0, int j0, const float* sv0, const float* sv1, bool sv_agent, bool silu, const float* addb, float* out, int ostride, LAS float* scr, int lane) {
#pragma unroll
    for (int h = 0; h < 2; ++h) { float c0 = sv_agent ? ld_agent(sv0 + k0 + 64 * h + lane) : sv0[k0 + 64 * h + lane], c1 = sv_agent ? ld_agent(sv1 + k0 + 64 * h + lane) : sv1[k0 + 64 * h + lane];
        if (silu) { c0 = c0 / (1.0f + expf(-c0)); c1 = c1 / (1.0f + expf(-c1)); }
        scr[64 * h + lane] = c0; scr[128 + 64 * h + lane] = c1; }
    LDS_WAIT(); asm volatile("" ::: "memory");
    float a0 = 0.f, a1 = 0.f;
    const float* wp_ = Wm + (size_t)k0 * ldw + j0 + lane;
#pragma unroll 32
    for (int kk = 0; kk < 128; ++kk) { const float w = wp_[(size_t)kk * ldw]; a0 += w * scr[kk]; a1 += w * scr[128 + kk]; }
    if (addb) { const float bv = addb[j0 + lane]; a0 += bv; a1 += bv; }
    atomicAdd(out + j0 + lane, a0); atomicAdd(out + ostride + j0 + lane, a1);
    LDS_WAIT(); asm volatile("" ::: "memory");
}
__device__ __forceinline__ void sincos_d(double x, float& s, float& c) {
    const double n = __builtin_rint(x * 0.63661977236758134308);
    double r = __builtin_fma(-n, 1.57079632679489655800e+00, x); r = __builtin_fma(-n, 6.12323399573676603587e-17, r);
    const int q = (int)n & 3; const double r2 = r * r;
    const double sp = r * (1.0 + r2 * (-1.0 / 6.0 + r2 * (1.0 / 120.0 + r2 * (-1.0 / 5040.0 + r2 * (1.0 / 362880.0 + r2 * (-1.0 / 39916800.0 + r2 * (1.0 / 6227020800.0 + r2 * (-1.0 / 1307674368000.0))))))));
    const double cp = 1.0 + r2 * (-0.5 + r2 * (1.0 / 24.0 + r2 * (-1.0 / 720.0 + r2 * (1.0 / 40320.0 + r2 * (-1.0 / 3628800.0 + r2 * (1.0 / 479001600.0 + r2 * (-1.0 / 87178291200.0 + r2 * (1.0 / 20922789888000.0))))))));
    const double sv = (q == 0) ? sp : (q == 1) ? cp : (q == 2) ? -sp : -cp, cv = (q == 0) ? cp : (q == 1) ? -sp : (q == 2) ? -cp : sp;
    s = (float)sv; c = (float)cv;
}

__device__ __forceinline__ void p0_prologue(Frame& F, const Args& a) {
    LAS float* scr = (LAS float*)(F.lds + RING_OFF + F.wave * 16896);
    const int gw = F.vcu * NWAVES + F.wave, NGW = F.G * NWAVES;
    const float* w_in = a.in[5]; const float* w_out = a.in[11]; const float* w_ff2 = a.in[14];
    unsigned short* Win = (unsigned short*)(F.ws + WS_WIN); unsigned short* Wsm = (unsigned short*)(F.ws + WS_WSM);
    unsigned short* Wout = (unsigned short*)(F.ws + WS_WOUT); unsigned short* Wff2 = (unsigned short*)(F.ws + WS_WFF2);
    constexpr int I_MOD = 96 * 8, I_IN = 16 * 48, I_SM = 16 * 2, I_OUT = 16 * 16, I_FF2 = 64 * 16;
    constexpr int NITEMS = I_MOD + I_IN + I_SM + I_OUT + I_FF2;
    for (int it = gw; it < NITEMS; it += NGW) {
        int r = it;
        if (r < I_MOD) {
            const int jb = r >> 3, ks = r & 7; float* mod = (float*)(F.ws + CTL_MOD);
            gemv_item(a.in[2], 6144, 128 * ks, 64 * jb, a.in[1], a.in[1] + D, false, true, ks == 0 ? a.in[3] : nullptr, mod, 6144, scr, F.lane); continue; }
        r -= I_MOD;
        if (r < I_IN) { const int kb = r / 48, nb = r % 48;
            int src[2];
#pragma unroll
            for (int e = 0; e < 2; ++e) { const int g = 2 * nb + e, pn = g >> 3, rem = g & 7, bj = rem >> 2, wc = rem & 3, sec = pn >> 1, head = 4 * (pn & 1) + wc;
                const int base = sec == 0 ? SEC_Q : sec == 1 ? SEC_K : sec == 2 ? SEC_V : sec == 3 ? SEC_QI : sec == 4 ? SEC_GU : SEC_GV; src[e] = base + head * 64 + 32 * bj; }
            tr_item64(w_in, IN_COLS, D, 64 * kb, src[0], src[1], Win, 64 * nb, nullptr, nullptr, scr, F.lane); continue; }
        r -= I_IN;
        if (r < I_SM) { const int kb = r >> 1, nb = r & 1; tr_item64(w_in, IN_COLS, D, 64 * kb, SEC_KI + 64 * nb, SEC_KI + 64 * nb + 32, Wsm, 64 * nb, nullptr, nullptr, scr, F.lane); continue; }
        r -= I_SM;
        if (r < I_OUT) { const int kb = r >> 4, nb = r & 15; const float* beta = (kb < 8) ? a.in[9] : (a.in[10] - 512);
            tr_item64(w_out, D, D, 64 * kb, 64 * nb, 64 * nb + 32, Wout, 64 * nb, beta, nullptr, scr, F.lane); continue; }
        r -= I_OUT;
        { const int kb = r >> 4, nb = r & 15; tr_item64(w_ff2, D, FF, 64 * kb, 64 * nb, 64 * nb + 32, Wff2, 64 * nb, nullptr, nullptr, scr, F.lane); }
    }
    { float* cosT = (float*)(F.ws + WS_COS); float* sinT = (float*)(F.ws + WS_SIN);
      for (int e = gw * 64 + F.lane; e < T * 32; e += NGW * 64) { const int pos = e >> 5, i = e & 31;
          const float ang = __fmul_rn((float)pos, a.inv_freq[i]); float s, c; sincos_d((double)ang, s, c); cosT[e] = c; sinT[e] = s; } }
    { const float* wsp = a.in[6]; unsigned short* o = (unsigned short*)(F.ws + WS_WSP);
      for (int e = gw * 64 + F.lane; e < 8 * 128 * 128 / 2; e += NGW * 64) { const int t = (2 * e >> 7) & 127, s = (2 * e) & 127;
          const float v0 = s <= t ? wsp[2 * e] : 0.f, v1 = (s + 1) <= t ? wsp[2 * e + 1] : 0.f; ((unsigned*)o)[e] = pkh(v0, v1); } }
}

__device__ __forceinline__ void p1_prologue(Frame& F, const Args& a) {
    LAS float* scr = (LAS float*)(F.lds + RING_OFF + F.wave * 16896);
    const int gw = F.vcu * NWAVES + F.wave, NGW = F.G * NWAVES;
    const float* mod = (const float*)(F.ws + CTL_MOD);
    const float* w_ff1 = a.in[13]; unsigned short* Wff1 = (unsigned short*)(F.ws + WS_WFF1);
    constexpr int I_B1 = 64 * 8, I_FF1 = 2 * 16 * 64;
    for (int it = gw; it < I_FF1 + I_B1; it += NGW) {
        int r = it;
        if (!(a.pad & 1)) break;
        if (r < I_B1) {
            if (a.pad & 8) continue;
            const int nb = r >> 3, ks = r & 7; float* b1 = (float*)(F.ws + CTL_BIAS1);
            gemv_item(w_ff1, FF, 128 * ks, 64 * nb, mod + 3072, mod + 6144 + 3072, true, false, nullptr, b1, FF, scr, F.lane); continue; }
        r -= I_B1;
        if (a.pad & 16) continue;
        { const int b = r / (16 * 64), rr = r % (16 * 64), kb = rr >> 6, nb = rr & 63;
          tr_item64(w_ff1, FF, D, 64 * kb, 64 * nb, 64 * nb + 32, Wff1 + (size_t)b * FF * D, 64 * nb, a.in[12], mod + b * 6144 + 4096, scr, F.lane); }
    }
    __syncthreads();
    const float* x = a.in[0]; const float* n1g = a.in[4];
    unsigned short* H1 = (unsigned short*)(F.ws + WS_H1); unsigned short* KI = (unsigned short*)(F.ws + WS_KI); float* WI = (float*)(F.ws + WS_WI);
    const unsigned short* Wsm = (const unsigned short*)(F.ws + WS_WSM);
    const float* cosT = (const float*)(F.ws + WS_COS); const float* sinT = (const float*)(F.ws + WS_SIN);
    constexpr int HSTR = 2064;
    for (int blk = F.vcu; blk < M / 64; blk += F.G) {
        const int row0 = 64 * blk, b = row0 >> 13;
        f32x4 gs[4], sh[4];
#pragma unroll
        for (int j = 0; j < 4; ++j) { const int c = 4 * F.lane + 256 * j;
#pragma unroll
            for (int e = 0; e < 4; ++e) { gs[j][e] = n1g[c + e] * (1.0f + ld_agent(mod + b * 6144 + 1024 + c + e)); sh[j][e] = ld_agent(mod + b * 6144 + c + e); } }
#pragma unroll 1
        for (int rb = 0; rb < ((a.pad & 2) ? 2 : 0); ++rb) {
            f32x4 v[4][4]; float s2[4];
#pragma unroll
            for (int rr = 0; rr < 4; ++rr) { const int row = row0 + 8 * F.wave + 4 * rb + rr; const GAS f32x4* xr = (const GAS f32x4*)(x + (size_t)row * D) + F.lane;
#pragma unroll
                for (int j = 0; j < 4; ++j) v[rr][j] = xr[64 * j]; }
#pragma unroll
            for (int rr = 0; rr < 4; ++rr) { float t = 0.f;
#pragma unroll
                for (int j = 0; j < 4; ++j) t += (v[rr][j].x * v[rr][j].x + v[rr][j].y * v[rr][j].y) + (v[rr][j].z * v[rr][j].z + v[rr][j].w * v[rr][j].w);
                s2[rr] = t; }
#pragma unroll
            for (int o = 1; o < 64; o <<= 1) {
#pragma unroll
                for (int rr = 0; rr < 4; ++rr) s2[rr] += __shfl_xor(s2[rr], o); }
#pragma unroll
            for (int rr = 0; rr < 4; ++rr) { const int rl = 8 * F.wave + 4 * rb + rr, row = row0 + rl; const float rstd = 1.0f / sqrtf(s2[rr] * (1.0f / D) + 1e-6f);
#pragma unroll
                for (int j = 0; j < 4; ++j) { const f32x4 hq = v[rr][j] * rstd * gs[j] + sh[j];
                    const unsigned long long pk = (unsigned long long)pkh(hq.x, hq.y) | ((unsigned long long)pkh(hq.z, hq.w) << 32);
                    *((GAS unsigned long long*)(H1 + (size_t)row * D) + F.lane + 64 * j) = pk;
                    *(LAS unsigned long long*)(F.lds + rl * HSTR + (4 * F.lane + 256 * j) * 2) = pk; } } }
        __syncthreads();
        if (a.pad & 4) { const int fr = F.lane & 15, fq = F.lane >> 4;
          if (F.wave < 4) {
              const int rt = F.wave; f32x4 acc[4];
#pragma unroll
              for (int ct = 0; ct < 4; ++ct) acc[ct] = (f32x4){0.f, 0.f, 0.f, 0.f};
#pragma unroll 2
              for (int ks = 0; ks < 32; ++ks) { const h8 hb = *(const LAS h8*)(F.lds + (16 * rt + fr) * HSTR + (32 * ks + 8 * fq) * 2);
#pragma unroll
                  for (int ct = 0; ct < 4; ++ct) { const h8 wa = *(const GAS h8*)(Wsm + (size_t)(16 * ct + fr) * D + 32 * ks + 8 * fq);
                      acc[ct] = __builtin_amdgcn_mfma_f32_16x16x32_f16(wa, hb, acc[ct], 0, 0, 0); } }
              const int row = row0 + 16 * rt + fr, pos = row & 8191; float n2 = 0.f;
#pragma unroll
              for (int ct = 0; ct < 2; ++ct) { const int d = 16 * ct + 4 * fq;
                  const f32x4 c = *(const f32x4*)(cosT + pos * 32 + d), s = *(const f32x4*)(sinT + pos * 32 + d);
                  const f32x4 lo = acc[ct] * c - acc[ct + 2] * s, hi = acc[ct] * s + acc[ct + 2] * c;
                  const unsigned l0 = pkh(lo[0], lo[1]), l1 = pkh(lo[2], lo[3]), h0 = pkh(hi[0], hi[1]), h1 = pkh(hi[2], hi[3]);
                  *(GAS unsigned long long*)(KI + (size_t)row * 64 + d) = (unsigned long long)l0 | ((unsigned long long)l1 << 32);
                  *(GAS unsigned long long*)(KI + (size_t)row * 64 + 32 + d) = (unsigned long long)h0 | ((unsigned long long)h1 << 32);
                  const f16x2_t a0 = __builtin_bit_cast(f16x2_t, l0), a1 = __builtin_bit_cast(f16x2_t, l1), b0 = __builtin_bit_cast(f16x2_t, h0), b1 = __builtin_bit_cast(f16x2_t, h1);
                  n2 += (float)a0[0] * (float)a0[0] + (float)a0[1] * (float)a0[1] + (float)a1[0] * (float)a1[0] + (float)a1[1] * (float)a1[1]
                      + (float)b0[0] * (float)b0[0] + (float)b0[1] * (float)b0[1] + (float)b1[0] * (float)b1[0] + (float)b1[1] * (float)b1[1]; }
              n2 += __shfl_xor(n2, 16); n2 += __shfl_xor(n2, 32);
#pragma unroll
              for (int o = 1; o < 16; o <<= 1) n2 = fmaxf(n2, __shfl_xor(n2, o));
              if (F.lane == 0) atomicMax((unsigned*)(F.ctl + CW_KMAX + b), __float_as_uint(n2));
          } else {
              const int rt = F.wave - 4; f32x4 acc = (f32x4){0.f, 0.f, 0.f, 0.f};
#pragma unroll 4
              for (int ks = 0; ks < 32; ++ks) { const h8 hb = *(const LAS h8*)(F.lds + (16 * rt + fr) * HSTR + (32 * ks + 8 * fq) * 2);
                  const h8 wa = *(const GAS h8*)(Wsm + (size_t)(64 + fr) * D + 32 * ks + 8 * fq);
                  acc = __builtin_amdgcn_mfma_f32_16x16x32_f16(wa, hb, acc, 0, 0, 0); }
              if (fq < 2) *(GAS f32x4*)(WI + (size_t)(row0 + 16 * rt + fr) * 8 + 4 * fq) = acc;
          } }
        __syncthreads();
    }
}

__device__ __forceinline__ void p8_final(Frame& F, const Args& a) {
    const int gw = F.vcu * NWAVES + F.wave, NGW = F.G * NWAVES;
    const float* fg = a.in[15]; const float* ss = (const float*)(F.ws + WS_SSX2);
    f32x4 g[4];
#pragma unroll
    for (int j = 0; j < 4; ++j) g[j] = *(const f32x4*)(fg + 4 * F.lane + 256 * j);
    for (int m = gw; m < M; m += NGW) {
        const float rstd = pg8::rstd_from16(ss + (size_t)m * 16, 1.0f / 1024.0f);
        GAS f32x4* xr = (GAS f32x4*)(a.out + (size_t)m * D) + F.lane;
#pragma unroll
        for (int j = 0; j < 4; ++j) xr[64 * j] = xr[64 * j] * rstd * g[j];
    }
}
__device__ __forceinline__ int crow16(int r, int hi) { return (r & 3) + 8 * (r >> 2) + 4 * hi; }
typedef short v4i16_g __attribute__((ext_vector_type(4)));
__device__ __forceinline__ void gmlp_unit(Frame& F, const Args& a, int b, int c, int hf) {
    const int g = F.wave, q = F.lane & 31, hi = F.lane >> 5;
    const size_t row0 = (size_t)b * T + 128 * c;
    const unsigned short* WSP = (const unsigned short*)(F.ws + WS_WSP); const unsigned short* VN = (const unsigned short*)(F.ws + WS_VN);
    const unsigned short* GU = (const unsigned short*)(F.ws + WS_GU); unsigned short* MRG = (unsigned short*)(F.ws + WS_MRG); float* SSG = (float*)(F.ws + WS_SSG);
    const float* bsp = a.in[7];
    LAS unsigned char* tile = F.lds + g * 16384;
    const int nrow = 64 * (hf + 1);
    for (int i = 0; i < nrow / 8; ++i) { const int rr = 8 * i + (F.lane >> 3), ch = F.lane & 7;
        *(LAS v4u*)(tile + rr * 128 + 16 * ch) = *(const GAS v4u*)(VN + (row0 + rr) * 512 + g * 64 + 8 * ch); }
    LDS_WAIT(); asm volatile("" ::: "memory");
    f32x16 acc[2][2];
#pragma unroll
    for (int rt = 0; rt < 2; ++rt)
#pragma unroll
        for (int dt = 0; dt < 2; ++dt) acc[rt][dt] = f32x16{};
    const LAS unsigned char* tb = tile + (8 * hi + ((F.lane & 15) >> 2)) * 128 + (((F.lane >> 4) & 1) * 16 + (F.lane & 3) * 4) * 2;
#pragma unroll
    for (int kk = 0; kk < 8; ++kk) if (kk < 4 * (hf + 1)) {
        h8 bf[2];
#pragma unroll
        for (int dt = 0; dt < 2; ++dt) { const LAS unsigned char* p = tb + (16 * kk) * 128 + (32 * dt) * 2;
            const v4i16_g lo = __builtin_amdgcn_ds_read_tr16_b64_v4i16((LAS v4i16_g*)p), hh = __builtin_amdgcn_ds_read_tr16_b64_v4i16((LAS v4i16_g*)(p + 4 * 128));
            typedef short s8 __attribute__((ext_vector_type(8))); const s8 t = {lo[0], lo[1], lo[2], lo[3], hh[0], hh[1], hh[2], hh[3]}; bf[dt] = __builtin_bit_cast(h8, t); }
#pragma unroll
        for (int rti = 0; rti < 2; ++rti) { const int rt = 2 * hf + rti;
            if (16 * kk <= 32 * rt + 31) { const h8 af = *(const GAS h8*)(WSP + (size_t)(g * 128 + 32 * rt + q) * 128 + 16 * kk + 8 * hi);
#pragma unroll
                for (int dt = 0; dt < 2; ++dt) acc[rti][dt] = __builtin_amdgcn_mfma_f32_32x32x16_f16(af, bf[dt], acc[rti][dt], 0, 0, 0); } }
    }
#pragma unroll
    for (int rti = 0; rti < 2; ++rti)
#pragma unroll
        for (int r = 0; r < 16; ++r) { const int t = 32 * (2 * hf + rti) + crow16(r, hi); const size_t row = row0 + t; const float bias = bsp[g * 128 + t]; float ss = 0.f;
#pragma unroll
            for (int dt = 0; dt < 2; ++dt) { const int d = g * 64 + 32 * dt + q; const float mixed = acc[rti][dt][r] + bias;
                const _Float16 gu = __builtin_bit_cast(_Float16, GU[row * 512 + d]); const _Float16 o = (_Float16)((float)gu * mixed);
                MRG[row * 1024 + 512 + d] = __builtin_bit_cast(unsigned short, o); ss += (float)o * (float)o; }
#pragma unroll
            for (int o = 1; o < 32; o <<= 1) ss += __shfl_xor(ss, o);
            if (q == 0) SSG[row * 8 + g] = ss; }
}

#define LAUNDER(v) asm volatile("" : "+v"(v))
constexpr int IX_HIST = 0, IX_IMG = 0, IX_CX = 32768, IX_CI = 65536, IX_SM = 131072, CCAP = 256;
__device__ __forceinline__ unsigned cm16(int q, int hi) { unsigned m = 0u;
#pragma unroll
    for (int r = 0; r < 16; ++r) m |= (crow16(r, hi) <= q) ? (1u << r) : 0u;
    return m; }
__device__ __forceinline__ void compute_x(const h8 (&kf)[4], const h8 (&qf)[8][4], const float (&wp)[8], const float x0, f32x16& x) {
#pragma unroll
    for (int r = 0; r < 16; ++r) x[r] = x0;
#pragma unroll
    for (int h = 0; h < 8; ++h) { f32x16 acc = f32x16{};
#pragma unroll
        for (int kk = 0; kk < 4; ++kk) acc = __builtin_amdgcn_mfma_f32_32x32x16_f16(kf[kk], qf[h][kk], acc, 0, 0, 0);
#pragma unroll
        for (int r = 0; r < 16; ++r) { const int ai = __float_as_int(acc[r]); const float m = __int_as_float(ai > 0 ? ai : 0);
            asm volatile("v_fmac_f32_e32 %0, %1, %2" : "+v"(x[r]) : "v"(wp[h]), "v"(m)); } }
}
__device__ __forceinline__ void index_unit(Frame& F, int b, int qb) {
    const int lane = F.lane, q = lane & 31, hi = lane >> 5, wid = F.wave;
    const size_t rowq = (size_t)b * T + 32 * qb + q;
    LAS unsigned* HIST = (LAS unsigned*)(F.lds + IX_HIST); LAS unsigned* IMG = (LAS unsigned*)(F.lds + IX_IMG);
    LAS float* CX = (LAS float*)(F.lds + IX_CX); LAS unsigned short* CI = (LAS unsigned short*)(F.lds + IX_CI);
    LAS unsigned* PART = (LAS unsigned*)(F.lds + IX_SM); LAS float* LO = (LAS float*)(F.lds + IX_SM + 1024); LAS float* HI = (LAS float*)(F.lds + IX_SM + 1152);
    LAS unsigned* NEED = (LAS unsigned*)(F.lds + IX_SM + 1280); LAS unsigned* CCNT = (LAS unsigned*)(F.lds + IX_SM + 1408);
    unsigned* MV = (unsigned*)(F.ws + WS_MASK) + ((size_t)(b * 256 + qb) * 128) * 64;
    const int ntw = 4 * ((qb >> 3) + 1);
    if (qb < 8) {
        int t_ = F.tid; LAUNDER(t_);
        for (int e = t_; e < ntw * 64; e += NWAVES * 64) { const int t64 = e >> 6, ln = e & 63; unsigned w = 0u;
#pragma unroll
            for (int p = 0; p < 2; ++p) { const int j = 2 * t64 + p; if (j < qb) w |= 0xFFFFu << (16 * p); else if (j == qb) w |= cm16(ln & 31, ln >> 5) << (16 * p); }
            MV[e] = w; }
        return; }
    const unsigned short* QI = (const unsigned short*)(F.ws + WS_QI); const unsigned short* KI = (const unsigned short*)(F.ws + WS_KI); const float* WI = (const float*)(F.ws + WS_WI);
    h8 qf[8][4]; float wp[8]; float Bp = 0.f, Bm = 0.f, x0;
#pragma unroll
    for (int h = 0; h < 8; ++h) { float n2 = 0.f;
#pragma unroll
        for (int kk = 0; kk < 4; ++kk) { qf[h][kk] = *(const GAS h8*)(QI + rowq * 512 + h * 64 + 16 * kk + 8 * hi);
#pragma unroll
            for (int j = 0; j < 8; ++j) { const float f = (float)qf[h][kk][j]; n2 += f * f; } }
        n2 += __shfl_xor(n2, 32);
        const float w = WI[rowq * 8 + h] * 0.35355339059327373f; wp[h] = w; const float bb = fabsf(w) * sqrtf(n2); if (w > 0.f) Bp += bb; else Bm += bb; }
    { const float kmax = sqrtf(__uint_as_float(__hip_atomic_load((unsigned*)(F.ctl + CW_KMAX + b), __ATOMIC_RELAXED, __HIP_MEMORY_SCOPE_AGENT)));
      const float kb = kmax * 0.125f * 1.03f; Bp *= kb; Bm *= kb;
      const float sc = (Bp + Bm) > 1e-30f ? 0.999f / (Bp + Bm) : 0.f; x0 = 1.0f + Bm * sc;
#pragma unroll
      for (int h = 0; h < 8; ++h) wp[h] *= 0.125f * sc; }
    { int t_ = F.tid; LAUNDER(t_); for (int e = t_; e < 8192; e += NWAVES * 64) ((LAS v4u*)HIST)[e] = (v4u){0u, 0u, 0u, 0u}; }
    __syncthreads();
    for (int j = wid; j <= qb; j += 8) {
        h8 kf[4]; const size_t rowk = (size_t)b * T + 32 * j + q;
#pragma unroll
        for (int kk = 0; kk < 4; ++kk) kf[kk] = *(const GAS h8*)(KI + rowk * 64 + 16 * kk + 8 * hi);
        f32x16 x; compute_x(kf, qf, wp, x0, x);
        const unsigned cm = (j < qb) ? 0xFFFFu : cm16(q, hi);
#pragma unroll
        for (int r = 0; r < 16; ++r) { const unsigned xb = ((cm >> r) & 1u) ? __float_as_uint(x[r]) : 0x3F800000u;
            const unsigned bin = (xb >> 13) & 1023u;
            __hip_atomic_fetch_add(HIST + bin * 32 + q, 1u, __ATOMIC_RELAXED, __HIP_MEMORY_SCOPE_WORKGROUP); }
    }
    __syncthreads();
    { int l_ = lane; LAUNDER(l_); const int q_ = l_ & 31, h_ = l_ >> 5; unsigned s = 0u;
#pragma unroll 16
      for (int i = 0; i < 64; ++i) s += HIST[(64 * (2 * wid + h_) + i) * 32 + q_];
      PART[(2 * wid + h_) * 32 + q_] = s; }
    __syncthreads();
    int ls_ = lane; LAUNDER(ls_);
    if (wid == 0 && ls_ < 32) { const int lane = ls_;
        unsigned A = 0u, Aseg = 0u; int seg = 0; bool found = false;
#pragma unroll
        for (int sg = 15; sg >= 0; --sg) { const unsigned p = PART[sg * 32 + lane]; const bool hit = !found && (A + p >= (unsigned)TOPK); if (hit) { seg = sg; Aseg = A; } found = found || hit; A += p; }
        A = Aseg; int bsel = 64 * seg; unsigned Asel = Aseg; found = false;
#pragma unroll 16
        for (int i = 63; i >= 0; --i) { const unsigned c = HIST[(64 * seg + i) * 32 + lane]; const bool hit = !found && (A + c >= (unsigned)TOPK); if (hit) { bsel = 64 * seg + i; Asel = A; } found = found || hit; A += c; }
        LO[lane] = __uint_as_float(0x3F800000u + ((unsigned)bsel << 13)); HI[lane] = __uint_as_float(0x3F800000u + ((unsigned)(bsel + 1) << 13));
        NEED[lane] = (Asel < (unsigned)TOPK) ? (unsigned)TOPK - Asel : 0u; }
    __syncthreads();
    { int t_ = F.tid; LAUNDER(t_); for (int e = t_; e < ntw * 64; e += NWAVES * 64) IMG[e] = 0u;
      if (t_ < 32) CCNT[t_] = 0u; }
    __syncthreads();
    { const float lo_e = LO[q], hi_e = HI[q];
      for (int j = wid; j <= qb; j += 8) {
        h8 kf[4]; const size_t rowk = (size_t)b * T + 32 * j + q;
#pragma unroll
        for (int kk = 0; kk < 4; ++kk) kf[kk] = *(const GAS h8*)(KI + rowk * 64 + 16 * kk + 8 * hi);
        f32x16 x; compute_x(kf, qf, wp, x0, x);
        const unsigned cm = (j < qb) ? 0xFFFFu : cm16(q, hi);
        unsigned w = 0u;
#pragma unroll
        for (int r = 15; r >= 0; --r) w = __builtin_amdgcn_alignbit(w, __float_as_uint(x[r] - hi_e), 31u);
        const unsigned sel = ~w & cm & 0xFFFFu;
        unsigned wl = 0u;
#pragma unroll
        for (int r = 15; r >= 0; --r) wl = __builtin_amdgcn_alignbit(wl, __float_as_uint(x[r] - lo_e), 31u);
        const unsigned cand = ~wl & w & cm & 0xFFFFu;
        if (__builtin_amdgcn_ballot_w64(cand != 0u) != 0ull)
#pragma unroll
        for (int r = 0; r < 16; ++r) {
            if ((cand >> r) & 1u) { const unsigned slot = __hip_atomic_fetch_add(CCNT + q, 1u, __ATOMIC_RELAXED, __HIP_MEMORY_SCOPE_WORKGROUP);
                if (slot < (unsigned)CCAP) { CX[q * CCAP + slot] = x[r]; CI[q * CCAP + slot] = (unsigned short)(32 * j + crow16(r, hi)); } } }
        ((LAS unsigned short*)IMG)[((j >> 1) * 64 + lane) * 2 + (j & 1)] = (unsigned short)sel;
      } }
    __syncthreads();
    int lr_ = lane; LAUNDER(lr_);
#pragma unroll 1
    for (int qi_ = 0; qi_ < 4; ++qi_) { const int lane = lr_; const int qq = 4 * wid + qi_; const unsigned cn = CCNT[qq]; const int C = (int)(cn < (unsigned)CCAP ? cn : (unsigned)CCAP); const unsigned nd = NEED[qq];
        unsigned long long kv[CCAP / 64]; unsigned rank[CCAP / 64];
#pragma unroll
        for (int c = 0; c < CCAP / 64; ++c) { const int i = 64 * c + lane; rank[c] = 0u;
            kv[c] = (i < C) ? (((unsigned long long)__float_as_uint(CX[qq * CCAP + i]) << 16) | (unsigned long long)(0xFFFFu - (unsigned)CI[qq * CCAP + i])) : 0ull; }
#pragma unroll
        for (int cb = 0; cb < CCAP / 64; ++cb) { const int nb = (C - 64 * cb) < 64 ? (C - 64 * cb) : 64;
            for (int jx = 0; jx < nb; ++jx) { const unsigned lo32 = (unsigned)__builtin_amdgcn_readlane((int)(unsigned)kv[cb], jx), hi32 = (unsigned)__builtin_amdgcn_readlane((int)(unsigned)(kv[cb] >> 32), jx);
                const unsigned long long kj = ((unsigned long long)hi32 << 32) | lo32;
#pragma unroll
                for (int c = 0; c < CCAP / 64; ++c) rank[c] += (kj > kv[c]) ? 1u : 0u; } }
#pragma unroll
        for (int c = 0; c < CCAP / 64; ++c) { const int i = 64 * c + lane;
            if (i < C && rank[c] < nd) { const unsigned ki = 0xFFFFu - (unsigned)(kv[c] & 0xFFFFull); const unsigned kk = ki & 31u, part = (ki >> 5) & 1u, t64 = ki >> 6, hh = (kk >> 2) & 1u, r = (kk & 3u) + 4u * (kk >> 3);
                __hip_atomic_fetch_or(IMG + t64 * 64 + hh * 32 + qq, 1u << (16u * part + r), __ATOMIC_RELAXED, __HIP_MEMORY_SCOPE_WORKGROUP); } }
    }
    __syncthreads();
    { int t_ = F.tid; LAUNDER(t_); for (int e = t_; e < ntw * 64; e += NWAVES * 64) MV[e] = IMG[e]; }
    __syncthreads();
}
__device__ __forceinline__ void p3_mixers(Frame& F, const Args& a) {
    for (int u = F.vcu; u < 256; u += F.G) gmlp_unit(F, a, u >> 7, (u & 127) >> 1, 1 - (u & 1));
    __syncthreads();
    for (int p = F.vcu; p < 256; p += F.G) { const int b = p >> 7, i = p & 127; index_unit(F, b, 255 - i); index_unit(F, b, i); }
}

constexpr int PER_PHASE = 9;
constexpr int N_LAUNCHES = MK_N_LAUNCHES;
__global__ void __launch_bounds__(NWAVES * 64, 2) hymba_fwd(Args args) {
    extern __shared__ __attribute__((aligned(16))) unsigned char lds[];
    Frame F;
    F.lds = (LAS unsigned char*)lds; F.MISC = (volatile LAS unsigned*)(F.lds + MISC_OFF);
    F.tid = threadIdx.x; F.lane = F.tid & 63; F.wave = __builtin_amdgcn_readfirstlane(F.tid >> 6);
    F.G = gridDim.x; { const int bx = blockIdx.x; F.vcu = (F.G % 8 == 0) ? (bx % 8) * (F.G / 8) + bx / 8 : bx; }
    F.ws = args.ws; F.ctl = (gu32*)(args.ws + WS_CTL);
    for (int u = F.tid; u < (LDS_BYTES - LDSCTL_OFF) / 4; u += NWAVES * 64) ((LAS unsigned*)(F.lds + LDSCTL_OFF))[u] = 0u;
    __syncthreads();
    if (N_LAUNCHES == 1) (void)xcd_barrier_post((unsigned*)(args.ws + WS_CTL) + CW_BAR, (volatile LAS unsigned*)((LAS unsigned char*)lds + MISC_OFF) + 8);
#define GRID_BAR() do { if (N_LAUNCHES == 1) { XcdBarrier bar_; bar_.bar = (unsigned*)(args.ws + WS_CTL) + CW_BAR; bar_.x = xb_xcc_id(); bar_.st = (volatile LAS unsigned*)((LAS unsigned char*)lds + MISC_OFF) + 8; xcd_barrier(bar_); } } while (0)
    const int lo = args.ph_lo, hi = args.ph_hi;
#ifndef PH_MASK
#define PH_MASK 0x1ff
#endif
#define IN(k) (((PH_MASK >> (k)) & 1) && lo <= (k) && (k) < hi)
#define BOTH(k) (IN(k) && IN((k) + 1))
    unsigned char* ws = args.ws;
    if (IN(0)) { p0_prologue(F, args); if (BOTH(0)) GRID_BAR(); }
    if (IN(1)) { p1_prologue(F, args); if (BOTH(1)) GRID_BAR(); }
#ifndef PH_REPEAT
#define PH_REPEAT -1
#endif
#define REP(k) for (int rep_ = 0; rep_ < ((PH_REPEAT == (k)) ? 2 : 1); ++rep_)
    if (IN(2)) {
        pg8::Gemm g{(const pg8::bf16_t*)(ws + WS_H1), (const pg8::bf16_t*)(ws + WS_WIN), M, NIN, D, 0}; pg8::StaticOrder S; S.init(M, NIN, F.G, (int)blockIdx.x);
        pg8::EpiInProj E{(unsigned short*)(ws + WS_Q), (unsigned short*)(ws + WS_K), (unsigned short*)(ws + WS_V), (unsigned short*)(ws + WS_QI), (unsigned short*)(ws + WS_GU), (unsigned short*)(ws + WS_VN),
                         (const float*)(ws + WS_COS), (const float*)(ws + WS_SIN), args.in[8]};
        REP(2) pg8::gemm_phase<pg8::EpiInProj, pg8::StaticOrder, true, true>(F.lds + RING_OFF, g, S, E);
        if (BOTH(2)) GRID_BAR();
    }
    if (IN(3)) { REP(3) p3_mixers(F, args); if (BOTH(3)) GRID_BAR(); }
    if (IN(4)) {
        const attn_body::AttnTensors AT{(const attn_body::bf16*)(ws + WS_Q), (const attn_body::bf16*)(ws + WS_K), (const attn_body::bf16*)(ws + WS_V), (unsigned short*)(ws + WS_MRG),
                                        (const unsigned*)(ws + WS_MASK), (float*)(ws + WS_SSA)};
        const attn_body::StaticOrder S((int)F.G, (int)blockIdx.x);
        REP(4) attn_body::attn_phase<attn_body::StaticOrder>((char*)lds + RING_OFF, AT, S);
        if (BOTH(4)) GRID_BAR();
    }
    if (IN(5)) {
        pg8::Gemm g{(const pg8::bf16_t*)(ws + WS_MRG), (const pg8::bf16_t*)(ws + WS_WOUT), M, D, D, 0}; pg8::StaticOrder S; S.init(M, D, F.G, (int)blockIdx.x);
        LAS float* rowf = (LAS float*)(F.lds + 131072);
        pg8::EpiOutProj E{args.in[0], args.out, (unsigned short*)(ws + WS_X1H), (const float*)(ws + CTL_MOD) + 2048, rowf, (float*)(ws + WS_SSX1)};
        REP(5) for (int i = 0;; ++i) { pg8::Unit u; if (!S.next(i, u)) break;
            if (F.tid < 256) { const size_t row = (size_t)u.pm * 256 + F.tid;
                const float ra = pg8::rstd_from8((const float*)(ws + WS_SSA) + row * 8, 1.0f / 512.0f), rg = pg8::rstd_from8((const float*)(ws + WS_SSG) + row * 8, 1.0f / 512.0f);
                rowf[2 * F.tid] = ra / rg; rowf[2 * F.tid + 1] = rg; }
            __syncthreads();
            pg8::SingleOrder S1{u};
            pg8::gemm_phase<pg8::EpiOutProj, pg8::SingleOrder, false, true>(F.lds + RING_OFF, g, S1, E);
            __syncthreads(); }
        if (BOTH(5)) GRID_BAR();
    }
    if (IN(6)) {
        pg8::Gemm g{(const pg8::bf16_t*)(ws + WS_X1H), (const pg8::bf16_t*)(ws + WS_WFF1), M, FF, D, (size_t)FF * D * 2}; pg8::StaticOrder S; S.init(M, FF, F.G, (int)blockIdx.x);
        pg8::EpiFF1 E{(unsigned short*)(ws + WS_U), (const float*)(ws + CTL_BIAS1), (const float*)(ws + WS_SSX1)};
        REP(6) pg8::gemm_phase<pg8::EpiFF1, pg8::StaticOrder, true, true>(F.lds + RING_OFF, g, S, E);
        if (BOTH(6)) GRID_BAR();
    }
    if (IN(7)) {
        pg8::Gemm g{(const pg8::bf16_t*)(ws + WS_U), (const pg8::bf16_t*)(ws + WS_WFF2), M, D, FF, 0}; pg8::StaticOrder S; S.init(M, D, F.G, (int)blockIdx.x);
        pg8::EpiFF2 E{args.out, (const float*)(ws + CTL_MOD) + 5120, (float*)(ws + WS_SSX2)};
        pg8::gemm_phase<pg8::EpiFF2, pg8::StaticOrder, false, true>(F.lds + RING_OFF, g, S, E);
        if (BOTH(7)) GRID_BAR();
    }
    if (IN(8)) p8_final(F, args);
#undef IN
#undef BOTH
}

extern "C" void kernel_launch(void* const* d_in, const int* in_sizes, int n_in, void* d_out, int out_size, void* d_ws, size_t ws_size, hipStream_t stream) {
    static int grid = 0;
    if (grid == 0) {
        if (n_in != 16 || in_sizes[0] != M * D || out_size != M * D || ws_size < WS_END) { fprintf(stderr, "kernel_launch: unexpected shapes (n_in %d, in0 %d, out %d, ws %zu); nothing launched\n", n_in, n_in > 0 ? in_sizes[0] : -1, out_size, ws_size); grid = -1; return; }
        int dev = 0, cus = 0, per_cu = 0;
        if (hipGetDevice(&dev) != hipSuccess || hipDeviceGetAttribute(&cus, hipDeviceAttributeMultiprocessorCount, dev) != hipSuccess) { grid = -1; return; }
        if (hipFuncSetAttribute((const void*)hymba_fwd, hipFuncAttributeMaxDynamicSharedMemorySize, LDS_BYTES) != hipSuccess) { fprintf(stderr, "kernel_launch: hipFuncSetAttribute failed\n"); grid = -1; return; }
        if (hipOccupancyMaxActiveBlocksPerMultiprocessor(&per_cu, (const void*)hymba_fwd, NWAVES * 64, LDS_BYTES) != hipSuccess || per_cu < 1)
            fprintf(stderr, "kernel_launch: note: occupancy query reports %d workgroups per CU\n", per_cu);
        (void)hipGetLastError();
        grid = cus < 256 ? (cus / 8) * 8 : 256;
        if (grid < 8) grid = cus;
    }
    if (grid < 0) return;
#if defined(PRE_PHASE)
    { Args a0{}; for (int i = 0; i < 16; ++i) a0.in[i] = (const float*)d_in[i]; a0.out = (float*)d_out; a0.ws = (unsigned char*)d_ws;
      for (int i = 0; i < 32; ++i) a0.inv_freq[i] = (float)pow(10000.0, -(double)i / 32.0);
      a0.ph_lo = PRE_PHASE; a0.ph_hi = PRE_PHASE + 1; a0.li = 0; a0.pad = PRE_PAD; hipLaunchKernelGGL(hymba_fwd, dim3(grid), dim3(NWAVES * 64), LDS_BYTES, stream, a0); }
#endif
    if (hipMemsetAsync((char*)d_ws + WS_CTL, 0, CTL_ZERO_BYTES, stream) != hipSuccess) { fprintf(stderr, "kernel_launch: hipMemsetAsync failed\n"); return; }
    Args a{};
    for (int i = 0; i < 16; ++i) a.in[i] = (const float*)d_in[i];
    a.out = (float*)d_out; a.ws = (unsigned char*)d_ws; a.pad = 7;
    for (int i = 0; i < 32; ++i) a.inv_freq[i] = (float)pow(10000.0, -(double)i / 32.0);
    const int last = MK_LAST_PHASE < PER_PHASE ? MK_LAST_PHASE : PER_PHASE;
    if (N_LAUNCHES == 1) { a.ph_lo = 0; a.ph_hi = last; a.li = 0; hipLaunchKernelGGL(hymba_fwd, dim3(grid), dim3(NWAVES * 64), LDS_BYTES, stream, a); }
    else for (int li = 0; li < last; ++li) { a.ph_lo = li; a.ph_hi = li + 1; a.li = li; hipLaunchKernelGGL(hymba_fwd, dim3(grid), dim3(NWAVES * 64), LDS_BYTES, stream, a);
#if defined(LAUNCH_TWICE)
        if (li == LAUNCH_TWICE) hipLaunchKernelGGL(hymba_fwd, dim3(grid), dim3(NWAVES * 64), LDS_BYTES, stream, a);
#endif
    }
    const hipError_t le = hipPeekAtLastError();
    if (le != hipSuccess) fprintf(stderr, "kernel_launch: launch failed: %s (grid %d)\n", hipGetErrorName(le), grid);
}
```
